# Optimizing an MI355X kernel written in HIP

```python
import jax, jax.numpy as jnp
from jax import lax
import numpy as np

D_MODEL = 1024
BATCH = 4
SEQ = 8192
DEPTH = 2

N_MIXERS = 2
EXPAND = 2
D_INNER = EXPAND * D_MODEL
CONV_WIDTH = 3
CHUNK = 128
GMLP_GROUPS = 8
GROUP_WIDTH = D_INNER // GMLP_GROUPS
N_CONV_LAYERS = (DEPTH + 1) // 2
N_GMLP_LAYERS = DEPTH // 2
RMS_EPS = 1e-6
LN_EPS = 1e-5

kernel_name = "hybrid_shortconv_chunked_gmlp_adaln"


def rms_norm(x, g):
    xf = x.astype(jnp.float32)
    y = xf * lax.rsqrt(jnp.mean(xf * xf, axis=-1, keepdims=True) + RMS_EPS)
    return (y * g.astype(jnp.float32)).astype(x.dtype)


def layer_norm(x, g, b):
    xf = x.astype(jnp.float32)
    mu = jnp.mean(xf, axis=-1, keepdims=True)
    var = jnp.mean(jnp.square(xf - mu), axis=-1, keepdims=True)
    y = (xf - mu) * lax.rsqrt(var + LN_EPS)
    return (y * g.astype(jnp.float32) + b.astype(jnp.float32)).astype(x.dtype)


def short_conv_mixer(h, w_in, conv_w, conv_b, w_out):
    seq = h.shape[1]
    proj = h @ w_in
    b_gate, c_gate, xin, z = jnp.split(proj, 4, axis=-1)
    cx = c_gate * xin
    padded = jnp.pad(cx, ((0, 0), (CONV_WIDTH - 1, 0), (0, 0)))
    conv = conv_b + conv_w[CONV_WIDTH - 1] * cx
    for k in range(CONV_WIDTH - 1):
        conv = conv + conv_w[k] * padded[:, k:k + seq]
    y = jax.nn.silu(z) * b_gate * conv
    return y @ w_out


def chunked_gmlp_mixer(h, w_in, ln_g, ln_b, w_s, b_s, w_out):
    bsz, seq, _ = h.shape
    proj = h @ w_in
    uv, z = proj[..., :2 * D_INNER], proj[..., 2 * D_INNER:]
    u, v = jnp.split(jax.nn.gelu(uv, approximate=False), 2, axis=-1)
    v = layer_norm(v, ln_g, ln_b)
    n_chunks = seq // CHUNK
    v = v.reshape(bsz, n_chunks, CHUNK, GMLP_GROUPS, GROUP_WIDTH)
    causal = jnp.tril(jnp.ones((CHUNK, CHUNK), dtype=bool))
    w = jnp.where(causal[None], w_s, jnp.zeros_like(w_s)).astype(v.dtype)
    mixed = jnp.einsum('gts,bnsgc->bntgc', w, v)
    mixed = mixed + jnp.transpose(b_s)[None, None, :, :, None].astype(v.dtype)
    s = u * mixed.reshape(bsz, seq, D_INNER)
    y = jax.nn.silu(z) * s
    return y @ w_out


def setup_inputs(seed: int = 0) -> dict:
    key = jax.random.key(seed)
    ks = jax.random.split(key, 20)
    nrm = jax.random.normal
    d, e = D_MODEL, D_INNER
    return {
        "x": nrm(ks[0], (BATCH, SEQ, d), jnp.float32),
        "c": nrm(ks[1], (BATCH, d), jnp.float32),
        "mod_w": nrm(ks[2], (DEPTH, d, 3 * d), jnp.float32) * (0.5 * d ** -0.5),
        "mod_b": nrm(ks[3], (DEPTH, 3 * d), jnp.float32) * 0.02,
        "norm_g": 1.0 + 0.05 * nrm(ks[4], (DEPTH, d), jnp.float32),
        "a_w_in": nrm(ks[5], (N_CONV_LAYERS, d, 4 * e), jnp.float32) * d ** -0.5,
        "a_conv_w": nrm(ks[6], (N_CONV_LAYERS, CONV_WIDTH, e), jnp.float32) * CONV_WIDTH ** -0.5,
        "a_conv_b": nrm(ks[7], (N_CONV_LAYERS, e), jnp.float32) * 0.02,
        "a_w_out": nrm(ks[8], (N_CONV_LAYERS, e, d), jnp.float32) * e ** -0.5,
        "b_w_in": nrm(ks[9], (N_GMLP_LAYERS, d, 3 * e), jnp.float32) * d ** -0.5,
        "b_ln_g": 1.0 + 0.05 * nrm(ks[10], (N_GMLP_LAYERS, e), jnp.float32),
        "b_ln_b": 0.02 * nrm(ks[11], (N_GMLP_LAYERS, e), jnp.float32),
        "b_w_s": nrm(ks[12], (N_GMLP_LAYERS, GMLP_GROUPS, CHUNK, CHUNK), jnp.float32) * CHUNK ** -0.5,
        "b_b_s": 1.0 + 0.1 * nrm(ks[13], (N_GMLP_LAYERS, GMLP_GROUPS, CHUNK), jnp.float32),
        "b_w_out": nrm(ks[14], (N_GMLP_LAYERS, e, d), jnp.float32) * e ** -0.5,
        "final_g": 1.0 + 0.05 * nrm(ks[15], (d,), jnp.float32),
    }


def reference(x, c, mod_w, mod_b, norm_g, a_w_in, a_conv_w, a_conv_b, a_w_out,
              b_w_in, b_ln_g, b_ln_b, b_w_s, b_b_s, b_w_out, final_g):
    c_act = jax.nn.silu(c)
    for i in range(DEPTH):
        mod = c_act @ mod_w[i] + mod_b[i]
        shift, scale, gate = jnp.split(mod[:, None, :], 3, axis=-1)
        h = rms_norm(x, norm_g[i]) * (1.0 + scale) + shift
        j = i // N_MIXERS
        if i % N_MIXERS == 0:
            branch = short_conv_mixer(h, a_w_in[j], a_conv_w[j], a_conv_b[j], a_w_out[j])
        else:
            branch = chunked_gmlp_mixer(h, b_w_in[j], b_ln_g[j], b_ln_b[j],
                                        b_w_s[j], b_b_s[j], b_w_out[j])
        x = x + gate * branch
    return rms_norm(x, final_g)
```

```cpp
#include <hip/hip_runtime.h>
#include <hip/hip_cooperative_groups.h>
#include <cstdio>
#include <cstdint>
namespace cg = cooperative_groups;

#define LAS __attribute__((address_space(3)))
typedef unsigned short bf16_t;
typedef short bf16x8 __attribute__((ext_vector_type(8)));
typedef float f32x4 __attribute__((ext_vector_type(4)));
typedef float f32x2 __attribute__((ext_vector_type(2)));
typedef unsigned u32x4 __attribute__((ext_vector_type(4)));
typedef unsigned u32x2 __attribute__((ext_vector_type(2)));

constexpr int DM = 1024, NB = 4, SEQ = 8192, DE = 2048, MT = NB * SEQ;
constexpr float RMS_EPS = 1e-6f, LN_EPS = 1e-5f;
constexpr int YP = DE + 64;

constexpr size_t MiB = 1u << 20;
constexpr size_t WS_CTL = 0, CTL_ZERO_BYTES = 256 * 1024;
constexpr size_t WS_MOD = 128 * 1024;
constexpr size_t WS_PART = 46 * MiB;
constexpr size_t WS_XS = 2 * MiB;
constexpr size_t WS_HG = 3 * MiB, WS_GG = 5 * MiB, WS_PC = 7 * MiB;
constexpr size_t WS_WS = 9 * MiB;
constexpr size_t WS_W1 = 10 * MiB;
constexpr size_t WS_W2 = 26 * MiB;
constexpr size_t WS_W3 = 30 * MiB;
constexpr size_t WS_W4 = 42 * MiB;
constexpr size_t WS_H = 48 * MiB;
constexpr size_t WS_Y = 112 * MiB;
constexpr size_t WS_VT = 248 * MiB;
constexpr size_t WS_X1 = 376 * MiB;
constexpr size_t WS_END = 440 * MiB;

constexpr int STAGE_BYTES = 131072, EPI_OFF = 131072, LDS_BYTES = 147456;

constexpr int BM = 256, BK = 64, HALF = 128, HTB = HALF * BK * 2, NXCD = 8, WGM = 8;
__host__ __device__ __forceinline__ int lds_byte(int r, int c) { const int st = (r >> 4) * 2 + (c >> 5), rr = r & 15, cc = c & 31, ob = rr * 64 + cc * 2; return st * 1024 + (ob ^ (((ob >> 9) & 1) << 5)); }
__host__ __device__ __forceinline__ void stage_rc(int b, int& R, int& C) { const int st = b / 1024, sb = b % 1024, swz = sb ^ (((sb >> 9) & 1) << 5); R = (st >> 1) * 16 + swz / 64; C = (st & 1) * 32 + (swz % 64) / 2; }
__host__ __device__ __forceinline__ int perm32(int rho) { const int n = rho >> 4, i = rho & 15; return 8 * (i >> 2) + 4 * n + (i & 3); }

struct Unit { int pm, pn; };
struct GemmDesc { const bf16_t* A; const bf16_t* Bt; int K; size_t tstepA, hstepA, tstepB, hstepB; int nM, nN; int ldA, ldB; };

struct StaticOrder {
    int nM, nN, nwg, G, c;
    __device__ void init(int nM_, int nN_, int G_, int c_) { nM = nM_; nN = nN_; nwg = nM * nN; G = G_; c = c_; }
    __device__ bool next(int i, Unit& u) const {
        const long L = (long)i * G + c; if (L >= nwg) return false;
        int wgid = (int)L; { const int q = nwg / NXCD, r = nwg % NXCD, xcd = wgid % NXCD, off = wgid / NXCD; wgid = (xcd < r ? xcd * (q + 1) : r * (q + 1) + (xcd - r) * q) + off; }
        const int nig = WGM * nN, gid = wgid / nig, fm = gid * WGM, gsz = (nM - fm) < WGM ? (nM - fm) : WGM;
        u.pm = fm + ((wgid % nig) % gsz); u.pn = (wgid % nig) / gsz; return true;
    }
};

__device__ __forceinline__ unsigned cvt_pk_bf16(float lo, float hi) { unsigned r; asm volatile("v_cvt_pk_bf16_f32 %0, %1, %2" : "=v"(r) : "v"(lo), "v"(hi)); return r; }
__device__ __forceinline__ f32x2 gelu_pk(f32x2 v) {
    const f32x2 av = __builtin_elementwise_abs(v), d = av * 0.2316418882f + 1.0f;
    f32x2 t; t.x = __builtin_amdgcn_rcpf(d.x); t.y = __builtin_amdgcn_rcpf(d.y);
    f32x2 q = t * 0.5307027145f + (-0.7265760135f); q = q * t + 0.7107068705f; q = q * t + (-0.142248368f); q = q * t + 0.127414796f; q = q * t;
    const f32x2 s = (v * v) * (-0.72134752044f);
    f32x2 e; e.x = __builtin_amdgcn_exp2f(s.x); e.y = __builtin_amdgcn_exp2f(s.y);
    const f32x2 c = 0.5f - q * e;
    return av * c + v * 0.5f;
}
__device__ __forceinline__ f32x4 gelu4(f32x4 v) { const f32x2 a = gelu_pk((f32x2){v[0], v[1]}), b = gelu_pk((f32x2){v[2], v[3]}); return (f32x4){a.x, a.y, b.x, b.y}; }
__device__ __forceinline__ float silu1(float z) { return z * __builtin_amdgcn_rcpf(1.0f + __builtin_amdgcn_exp2f(-1.4426950408889634f * z)); }
__device__ __forceinline__ f32x2 silu2(f32x2 z) {
    const f32x2 a = z * (-1.4426950408889634f);
    f32x2 e; e.x = __builtin_amdgcn_exp2f(a.x); e.y = __builtin_amdgcn_exp2f(a.y);
    const f32x2 d = e + 1.0f;
    f32x2 r; r.x = __builtin_amdgcn_rcpf(d.x); r.y = __builtin_amdgcn_rcpf(d.y);
    return z * r;
}
__device__ __forceinline__ f32x4 silu4(f32x4 z) { const f32x2 a = silu2((f32x2){z[0], z[1]}), b = silu2((f32x2){z[2], z[3]}); return (f32x4){a.x, a.y, b.x, b.y}; }
#define EPI_BARRIER() do { asm volatile("s_waitcnt lgkmcnt(0)" ::: "memory"); __builtin_amdgcn_s_barrier(); asm volatile("" ::: "memory"); } while (0)


struct EpiConv {
    static __host__ __device__ __forceinline__ int brow(int R) { return ((R >> 4) & 1) * 2048 + (R >> 5) * 16 + (R & 15); }
    bf16_t* Y; const float* cw; const float* cb; float* HG; float* GG; float* PC;
    __device__ __forceinline__ void operator()(f32x4 (&acc)[2][2][4][2], const Unit& u, int wr, int wc, int fr, int fq, LAS unsigned char* lds, int tid) const {
        LAS float* halo = (LAS float*)(lds + EPI_OFF);
        const int jl = 16 * wc + 4 * fq, j = 64 * u.pn + jl;
#pragma unroll
        for (int ai = 0; ai < 2; ++ai)
#pragma unroll
            for (int m = 0; m < 4; ++m) {
                const f32x4 Bg = acc[ai][0][m][0], Cg = acc[ai][0][m][1], Xi = acc[ai][1][m][0], Z = acc[ai][1][m][1];
                const f32x4 cx = Cg * Xi, g = silu4(Z) * Bg;
                acc[ai][0][m][1] = cx; acc[ai][1][m][1] = g;
                const int G = ai * 8 + wr * 4 + m;
                if (fr >= 14) {
                    *(LAS f32x4*)(halo + (G * 2 + (fr - 14)) * 64 + jl) = cx;
                    if (G == 15) *(f32x4*)(HG + ((size_t)(u.pm * 2 + (fr - 14))) * 2048 + j) = cx;
                }
            }
        EPI_BARRIER();
        const f32x4 w0 = *(const f32x4*)(cw + j), w1 = *(const f32x4*)(cw + 2048 + j), w2 = *(const f32x4*)(cw + 4096 + j), cbv = *(const f32x4*)(cb + j);
#pragma unroll
        for (int ai = 0; ai < 2; ++ai)
#pragma unroll
            for (int m = 0; m < 4; ++m) {
                const int G = ai * 8 + wr * 4 + m;
                const f32x4 cx = acc[ai][0][m][1], g = acc[ai][1][m][1];
                f32x4 h1 = (f32x4){0.f, 0.f, 0.f, 0.f}, hB = h1;
                if (G > 0) { h1 = *(const LAS f32x4*)(halo + ((G - 1) * 2 + 1) * 64 + jl); hB = *(const LAS f32x4*)(halo + ((G - 1) * 2 + (fr < 1 ? 0 : 1)) * 64 + jl); }
                f32x4 p1, p2;
#pragma unroll
                for (int e = 0; e < 4; ++e) { p1[e] = __shfl_up(cx[e], 1, 16); p2[e] = __shfl_up(cx[e], 2, 16); }
                if (fr < 1) p1 = h1;
                if (fr < 2) p2 = hB;
                const f32x4 pc = cbv + w2 * cx + w1 * p1 + w0 * p2, yv = g * pc;
                const size_t row = (size_t)u.pm * 256 + 16 * G + fr;
                u32x2 w; w.x = cvt_pk_bf16(yv[0], yv[1]); w.y = cvt_pk_bf16(yv[2], yv[3]);
                *(u32x2*)(Y + row * YP + j) = w;
                if (G == 0 && fr < 2) { *(f32x4*)(GG + ((size_t)(u.pm * 2 + fr)) * 2048 + j) = g; *(f32x4*)(PC + ((size_t)(u.pm * 2 + fr)) * 2048 + j) = pc; }
            }
    }
};

struct EpiRes {
    static __host__ __device__ __forceinline__ int brow(int R) { return R; }
    const float* xin; float* out; const float* gate;
    __device__ __forceinline__ void operator()(f32x4 (&acc)[2][2][4][2], const Unit& u, int wr, int wc, int fr, int fq, LAS unsigned char* lds, int tid) const {
        const int row0 = u.pm * BM + wr * 64 + fr, col0 = u.pn * BM + wc * 32 + 4 * fq;
        const float* gp = gate + (size_t)(u.pm >> 5) * 3072 + col0;
        f32x4 gv[2][2];
#pragma unroll
        for (int bj = 0; bj < 2; ++bj)
#pragma unroll
            for (int n = 0; n < 2; ++n) gv[bj][n] = *(const f32x4*)(gp + bj * HALF + n * 16);
#pragma unroll
        for (int ai = 0; ai < 2; ++ai)
#pragma unroll
            for (int m = 0; m < 4; ++m) { const size_t off = (size_t)(row0 + ai * HALF + m * 16) * DM + col0;
#pragma unroll
                for (int bj = 0; bj < 2; ++bj)
#pragma unroll
                    for (int n = 0; n < 2; ++n) { const f32x4 xv = *(const f32x4*)(xin + off + bj * HALF + n * 16); *(f32x4*)(out + off + bj * HALF + n * 16) = xv + gv[bj][n] * acc[ai][bj][m][n]; }
                if (m & 1) asm volatile("" ::: "memory"); }
    }
};

template <int MODE> struct EpiResNorm {
    static __host__ __device__ __forceinline__ int brow(int R) { return (R & ~31) + perm32(R & 31); }
    const float* xin; float* out; bf16_t* Hn; const float* gate; const float* gam; const float* modl; float* XS; unsigned* cnt; bf16_t* X1;
    __device__ __forceinline__ void operator()(f32x4 (&acc)[2][2][4][2], const Unit& u_, int wr_, int wc_, int fr_, int fq_, LAS unsigned char* lds, int tid_) const {
        Unit u; u.pm = u_.pm; u.pn = u_.pn; asm volatile("" : "+s"(u.pm), "+s"(u.pn));
        int tid = tid_; asm volatile("" : "+v"(tid));
        const int wid = __builtin_amdgcn_readfirstlane(tid >> 6), wr = wid >> 2, wc = wid & 3, fr = tid & 15, fq = (tid >> 4) & 3;
        LAS float* P = (LAS float*)(lds + EPI_OFF);
        LAS float* S = (LAS float*)(lds + EPI_OFF + 4096);
        const int b = u.pm >> 5;
        const int row0 = u.pm * BM + wr * 64 + fr, col0 = u.pn * BM + wc * 32 + 8 * fq;
        {
            f32x4 gv[2][2];
#pragma unroll
            for (int bj = 0; bj < 2; ++bj)
#pragma unroll
                for (int n = 0; n < 2; ++n) gv[bj][n] = *(const f32x4*)(gate + (size_t)b * 3072 + col0 + bj * HALF + 4 * n);
            if (MODE == 0) {
#pragma unroll
            for (int ai = 0; ai < 2; ++ai) {
                f32x4 xt[4][2][2];
#pragma unroll
                for (int m = 0; m < 4; ++m) { const unsigned off = (unsigned)(row0 + ai * HALF + m * 16) * DM + col0;
#pragma unroll
                    for (int bj = 0; bj < 2; ++bj)
#pragma unroll
                        for (int n = 0; n < 2; ++n) xt[m][bj][n] = *(const f32x4*)(xin + off + bj * HALF + 4 * n); }
#pragma unroll
                for (int m = 0; m < 4; ++m) {
#pragma unroll
                    for (int bj = 0; bj < 2; ++bj)
#pragma unroll
                        for (int n = 0; n < 2; ++n) acc[ai][bj][m][n] = xt[m][bj][n] + gv[bj][n] * acc[ai][bj][m][n];
                    asm volatile("" : "+v"(acc[ai][0][m][0]), "+v"(acc[ai][0][m][1]), "+v"(acc[ai][1][m][0]), "+v"(acc[ai][1][m][1]));
                }
                asm volatile("" ::: "memory"); __builtin_amdgcn_sched_barrier(0);
            }
            } else {
#pragma unroll
            for (int ai = 0; ai < 2; ++ai) {
                u32x4 xb[4][2];
#pragma unroll
                for (int m = 0; m < 4; ++m) { const unsigned off = (unsigned)(row0 + ai * HALF + m * 16) * DM + col0;
#pragma unroll
                    for (int bj = 0; bj < 2; ++bj) xb[m][bj] = *(const u32x4*)(X1 + off + bj * HALF); }
#pragma unroll
                for (int m = 0; m < 4; ++m) {
#pragma unroll
                    for (int bj = 0; bj < 2; ++bj) { const u32x4 w = xb[m][bj];
                        const f32x4 xa = (f32x4){__uint_as_float(w.x << 16), __uint_as_float(w.x & 0xffff0000u), __uint_as_float(w.y << 16), __uint_as_float(w.y & 0xffff0000u)};
                        const f32x4 xc = (f32x4){__uint_as_float(w.z << 16), __uint_as_float(w.z & 0xffff0000u), __uint_as_float(w.w << 16), __uint_as_float(w.w & 0xffff0000u)};
                        acc[ai][bj][m][0] = xa + gv[bj][0] * acc[ai][bj][m][0]; acc[ai][bj][m][1] = xc + gv[bj][1] * acc[ai][bj][m][1]; }
                    asm volatile("" : "+v"(acc[ai][0][m][0]), "+v"(acc[ai][0][m][1]), "+v"(acc[ai][1][m][0]), "+v"(acc[ai][1][m][1]));
                }
                asm volatile("" ::: "memory"); __builtin_amdgcn_sched_barrier(0);
            }
            }
        }
#pragma unroll
        for (int ai = 0; ai < 2; ++ai)
#pragma unroll
            for (int m = 0; m < 4; ++m) { float ss = 0.f;
#pragma unroll
                for (int bj = 0; bj < 2; ++bj)
#pragma unroll
                    for (int n = 0; n < 2; ++n) { const f32x4 v = acc[ai][bj][m][n]; ss += (v[0] * v[0] + v[1] * v[1]) + (v[2] * v[2] + v[3] * v[3]); }
                ss += __shfl_xor(ss, 16); ss += __shfl_xor(ss, 32);
                if (fq == 0) P[(ai * HALF + wr * 64 + m * 16 + fr) * 4 + wc] = ss; }
        EPI_BARRIER();
        if (wid < 4) {
            const f32x4 p = *(const LAS f32x4*)(P + tid * 4);
            __hip_atomic_store(XS + ((size_t)(u.pm * 4 + u.pn)) * 256 + tid, (p[0] + p[1]) + (p[2] + p[3]), __ATOMIC_RELAXED, __HIP_MEMORY_SCOPE_AGENT);
            asm volatile("s_waitcnt vmcnt(0)" ::: "memory");
            if ((tid & 63) == 0) __hip_atomic_fetch_add(cnt + 64 * u.pm, 1u, __ATOMIC_RELAXED, __HIP_MEMORY_SCOPE_AGENT);
        }
        if (MODE == 0) {
#pragma unroll
            for (int ai = 0; ai < 2; ++ai)
#pragma unroll
                for (int m = 0; m < 4; ++m) { const unsigned off = (unsigned)(row0 + ai * HALF + m * 16) * DM + col0;
#pragma unroll
                    for (int bj = 0; bj < 2; ++bj) { const f32x4 a = acc[ai][bj][m][0], c = acc[ai][bj][m][1];
                        u32x4 w; w.x = cvt_pk_bf16(a[0], a[1]); w.y = cvt_pk_bf16(a[2], a[3]); w.z = cvt_pk_bf16(c[0], c[1]); w.w = cvt_pk_bf16(c[2], c[3]);
                        *(u32x4*)(X1 + off + bj * HALF) = w; } }
        }
        if (wid == 0) {
            unsigned sp = 0;
            while ((unsigned)__builtin_amdgcn_readfirstlane(__hip_atomic_load(cnt + 64 * u.pm, __ATOMIC_RELAXED, __HIP_MEMORY_SCOPE_AGENT)) < 16u) { __builtin_amdgcn_s_sleep(1); if (++sp > (1u << 20)) break; }
            __builtin_amdgcn_fence(__ATOMIC_ACQUIRE, "agent");
            asm volatile("s_waitcnt vmcnt(0)" ::: "memory");
        }
        EPI_BARRIER();
        if (wid < 4) { float t = 0.f;
#pragma unroll
            for (int p = 0; p < 4; ++p) t += __hip_atomic_load(XS + ((size_t)(u.pm * 4 + p)) * 256 + tid, __ATOMIC_RELAXED, __HIP_MEMORY_SCOPE_AGENT);
            S[tid] = 1.0f / sqrtf(t * (1.0f / DM) + RMS_EPS); }
        EPI_BARRIER();
#pragma unroll
        for (int bj = 0; bj < 2; ++bj) {
            f32x4 mul[2], sh[2];
#pragma unroll
            for (int n = 0; n < 2; ++n) { const int c = col0 + bj * HALF + 4 * n; const f32x4 gg = *(const f32x4*)(gam + c);
                if (MODE == 0) { const f32x4 sc = *(const f32x4*)(modl + (size_t)b * 3072 + 1024 + c); mul[n] = gg * (sc + 1.0f); sh[n] = *(const f32x4*)(modl + (size_t)b * 3072 + c); }
                else { mul[n] = gg; sh[n] = (f32x4){0.f, 0.f, 0.f, 0.f}; } }
#pragma unroll
            for (int ai = 0; ai < 2; ++ai)
#pragma unroll
                for (int m = 0; m < 4; ++m) { const int r = ai * HALF + wr * 64 + m * 16 + fr; const float rs = S[r]; const unsigned off = (unsigned)(u.pm * BM + r) * DM + col0 + bj * HALF;
                    const f32x4 o0 = acc[ai][bj][m][0] * rs * mul[0] + sh[0], o1 = acc[ai][bj][m][1] * rs * mul[1] + sh[1];
                    if (MODE == 0) { u32x4 w; w.x = cvt_pk_bf16(o0[0], o0[1]); w.y = cvt_pk_bf16(o0[2], o0[3]); w.z = cvt_pk_bf16(o1[0], o1[1]); w.w = cvt_pk_bf16(o1[2], o1[3]); *(u32x4*)(Hn + off) = w; }
                    else { *(f32x4*)(out + off) = o0; *(f32x4*)(out + off + 4) = o1; } }
            asm volatile("" ::: "memory");
        }
    }
};

__device__ __forceinline__ float row16_sum(float x) {
    x += __builtin_bit_cast(float, __builtin_amdgcn_update_dpp(0, __builtin_bit_cast(int, x), 0x128, 0xf, 0xf, true));
    x += __builtin_bit_cast(float, __builtin_amdgcn_update_dpp(0, __builtin_bit_cast(int, x), 0x124, 0xf, 0xf, true));
    x += __builtin_bit_cast(float, __builtin_amdgcn_update_dpp(0, __builtin_bit_cast(int, x), 0x122, 0xf, 0xf, true));
    x += __builtin_bit_cast(float, __builtin_amdgcn_update_dpp(0, __builtin_bit_cast(int, x), 0x121, 0xf, 0xf, true));
    return x;
}
struct EpiV {
    static __host__ __device__ __forceinline__ int brow(int R) { return (R & ~31) + perm32(R & 31); }
    bf16_t* VT; f32x2* PART;
    __device__ __forceinline__ void operator()(f32x4 (&acc)[2][2][4][2], const Unit& u, int wr, int wc, int fr, int fq, LAS unsigned char* lds, int tid) const {
        LAS float* red = (LAS float*)(lds + EPI_OFF);
#pragma unroll
        for (int bj = 0; bj < 2; ++bj) {
            const int chunk = 2 * u.pn + bj;
            f32x4 s0 = (f32x4){0.f, 0.f, 0.f, 0.f}, s1 = s0, q0 = s0, q1 = s0;
#pragma unroll
            for (int ai = 0; ai < 2; ++ai)
#pragma unroll
                for (int m = 0; m < 4; ++m) {
                    const int f = 256 * u.pm + 128 * ai + 64 * wr + 16 * m + fr;
                    const f32x4 v0 = gelu4(acc[ai][bj][m][0]), v1 = gelu4(acc[ai][bj][m][1]);
                    s0 += v0; s1 += v1; q0 += v0 * v0; q1 += v1 * v1;
                    u32x4 w; w.x = cvt_pk_bf16(v0[0], v0[1]); w.y = cvt_pk_bf16(v0[2], v0[3]); w.z = cvt_pk_bf16(v1[0], v1[1]); w.w = cvt_pk_bf16(v1[2], v1[3]);
                    *(u32x4*)(VT + ((size_t)chunk * 2048 + f) * 128 + 32 * wc + 8 * fq) = w;
                }
#pragma unroll
            for (int e = 0; e < 4; ++e) { s0[e] = row16_sum(s0[e]); s1[e] = row16_sum(s1[e]); q0[e] = row16_sum(q0[e]); q1[e] = row16_sum(q1[e]); }
            if (fr == 0) {
                LAS f32x4* rp = (LAS f32x4*)(red + ((size_t)((wr * 2 + bj) * 128) + 32 * wc + 8 * fq) * 2);
                rp[0] = (f32x4){s0[0], q0[0], s0[1], q0[1]}; rp[1] = (f32x4){s0[2], q0[2], s0[3], q0[3]};
                rp[2] = (f32x4){s1[0], q1[0], s1[1], q1[1]}; rp[3] = (f32x4){s1[2], q1[2], s1[3], q1[3]};
            }
        }
        EPI_BARRIER();
        if (tid < 256) { const LAS f32x2* r2 = (const LAS f32x2*)red; const int bj = tid >> 7, t = tid & 127;
            const f32x2 a = r2[(0 * 2 + bj) * 128 + t], b = r2[(1 * 2 + bj) * 128 + t];
            PART[(size_t)u.pm * MT + 256 * u.pn + tid] = a + b; }
    }
};

struct EpiMix {
    static __host__ __device__ __forceinline__ int brow(int R) { return (R & ~31) + perm32(R & 31); }
    bf16_t* Y; const bf16_t* VT; const bf16_t* WS; const f32x2* stats; const float* lng; const float* lnb; const float* bs;
    __device__ __forceinline__ void operator()(f32x4 (&acc)[2][2][4][2], const Unit& u_, int wr_, int wc_, int fr_, int fq_, LAS unsigned char* lds, int tid_) const {
        Unit u; u.pm = u_.pm; u.pn = u_.pn; asm volatile("" : "+s"(u.pm), "+s"(u.pn));
        int tid = tid_; asm volatile("" : "+v"(tid));
        const int wid = __builtin_amdgcn_readfirstlane(tid >> 6), wr = wid >> 2, wc = wid & 3, fr = tid & 15, fq = (tid >> 4) & 3;
        LAS float* TSA = (LAS float*)(lds + EPI_OFF);
        LAS float* TSB = (LAS float*)(lds + EPI_OFF + 1024);
        const int grp = u.pn >> 1, j0 = 128 * u.pn;
        const int jx = j0 + 32 * wc + 8 * (fr >> 2) + (fr & 3);
        const bf16_t* vbase = VT + ((size_t)(2 * u.pm) * 2048 + jx) * 128 + 8 * fq;
        u32x4 raw[2][4];
#pragma unroll
        for (int n = 0; n < 2; ++n)
#pragma unroll
            for (int k = 0; k < 4; ++k) raw[n][k] = *(const u32x4*)(vbase + n * 512 + 32 * k);
        if (tid < 256) { const unsigned tok = 256u * u.pm + tid; f32x2 sq = stats[tok];
#pragma unroll
            for (int p = 1; p < 8; ++p) sq += stats[(size_t)p * MT + tok];
            const float mean = sq.x * (1.0f / 2048.0f); float var = sq.y * (1.0f / 2048.0f) - mean * mean; var = var < 0.f ? 0.f : var;
            const float rstd = 1.0f / sqrtf(var + LN_EPS); TSA[tid] = rstd; TSB[tid] = -mean * rstd; }
        float lg[2], lb[2];
#pragma unroll
        for (int n = 0; n < 2; ++n) { lg[n] = lng[jx + 4 * n]; lb[n] = lnb[jx + 4 * n]; }
        EPI_BARRIER();
#pragma unroll
        for (int ai = 0; ai < 2; ++ai) {
            bf16x8 Xf[2][4];
#pragma unroll
            for (int n = 0; n < 2; ++n)
#pragma unroll
                for (int k = 0; k < 4; ++k) {
                    const LAS f32x4* ta = (const LAS f32x4*)(TSA + 128 * ai + 32 * k + 8 * fq);
                    const LAS f32x4* tb = (const LAS f32x4*)(TSB + 128 * ai + 32 * k + 8 * fq);
                    const f32x4 a0 = ta[0], a1 = ta[1], b0 = tb[0], b1 = tb[1];
                    const f32x2 lg2 = (f32x2){lg[n], lg[n]}, lb2 = (f32x2){lb[n], lb[n]};
                    u32x4 o;
#pragma unroll
                    for (int h = 0; h < 4; ++h) { const unsigned wd = raw[n][k][h];
                        const f32x2 f = (f32x2){__uint_as_float(wd << 16), __uint_as_float(wd & 0xffff0000u)};
                        const f32x2 aa = h == 0 ? (f32x2){a0[0], a0[1]} : h == 1 ? (f32x2){a0[2], a0[3]} : h == 2 ? (f32x2){a1[0], a1[1]} : (f32x2){a1[2], a1[3]};
                        const f32x2 bb = h == 0 ? (f32x2){b0[0], b0[1]} : h == 1 ? (f32x2){b0[2], b0[3]} : h == 2 ? (f32x2){b1[0], b1[1]} : (f32x2){b1[2], b1[3]};
                        const f32x2 v = (f * aa + bb) * lg2 + lb2;
                        o[h] = cvt_pk_bf16(v.x, v.y); }
                    Xf[n][k] = __builtin_bit_cast(bf16x8, o);
                }
            if (ai == 0) {
#pragma unroll
                for (int n = 0; n < 2; ++n)
#pragma unroll
                    for (int k = 0; k < 4; ++k) raw[n][k] = *(const u32x4*)(vbase + (size_t)2048 * 128 + n * 512 + 32 * k);
            }
#pragma unroll
            for (int m = 0; m < 4; ++m) {
                const int t = 64 * wr + 16 * m + fr;
                const bf16_t* wp = WS + ((size_t)grp * 128 + t) * 128 + 8 * fq;
                bf16x8 Yf[4];
#pragma unroll
                for (int k = 0; k < 4; ++k) Yf[k] = *(const bf16x8*)(wp + 32 * k);
                const float bst = bs[grp * 128 + t];
                f32x4 mx0 = (f32x4){0.f, 0.f, 0.f, 0.f}, mx1 = mx0;
#pragma unroll
                for (int k = 0; k < 4; ++k) { mx0 = __builtin_amdgcn_mfma_f32_16x16x32_bf16(Xf[0][k], Yf[k], mx0, 0, 0, 0); mx1 = __builtin_amdgcn_mfma_f32_16x16x32_bf16(Xf[1][k], Yf[k], mx1, 0, 0, 0); }
                const f32x4 y0 = silu4(acc[ai][1][m][0]) * (gelu4(acc[ai][0][m][0]) * (mx0 + bst));
                const f32x4 y1 = silu4(acc[ai][1][m][1]) * (gelu4(acc[ai][0][m][1]) * (mx1 + bst));
                u32x4 w; w.x = cvt_pk_bf16(y0[0], y0[1]); w.y = cvt_pk_bf16(y0[2], y0[3]); w.z = cvt_pk_bf16(y1[0], y1[1]); w.w = cvt_pk_bf16(y1[2], y1[3]);
                *(u32x4*)(Y + ((size_t)256 * u.pm + 128 * ai + t) * YP + j0 + 32 * wc + 8 * fq) = w;
            }
        }
    }
};

__device__ __forceinline__ f32x4 zero4() {
    f32x2 lo, hi;
    asm volatile("v_mov_b64 %0, 0" : "=v"(lo)); asm volatile("v_mov_b64 %0, 0" : "=v"(hi));
    return (f32x4){lo.x, lo.y, hi.x, hi.y};
}
template <class Epi>
__device__ __forceinline__ void gemm_phase(LAS unsigned char* lds, const GemmDesc g, const StaticOrder& S, const Epi& E) {
    const int tid = threadIdx.x, wid = __builtin_amdgcn_readfirstlane(tid >> 6), lane = tid & 63, wr = wid >> 2, wc = wid & 3, fr = lane & 15, fq = lane >> 4;
    const int K = g.K, nt = K / BK;
    unsigned voffA[2], voffB[2];
#pragma unroll
    for (int i = 0; i < 2; ++i) { int R, C; stage_rc(tid * 16 + i * 8192, R, C); voffA[i] = (unsigned)(R * g.ldA + C) * 2u; voffB[i] = (unsigned)(Epi::brow(R) * g.ldB + C) * 2u; }
    const size_t kstep = (size_t)(BK * 2);
    const size_t hstepA = g.hstepA, hstepB = g.hstepB;
    const unsigned ldsw = (unsigned)wid * 1024u;
    const int aoff = lds_byte(wr * 64 + fr, fq * 8), boff = lds_byte(wc * 32 + fr, fq * 8);
#define PG8_SA(b, h) (((b) * 2 + (h)) * HTB)
#define PG8_SB(b, h) ((4 + (b) * 2 + (h)) * HTB)
#define PG8_STAGE(bufoff, gbase, voff) do { _Pragma("unroll") for (int _i = 0; _i < 2; ++_i) \
        __builtin_amdgcn_global_load_lds((const unsigned*)((const char*)(gbase) + (voff)[_i]), (LAS unsigned*)(lds + (bufoff) + ldsw + _i * 8192), 16, 0, 0); } while (0)
#define PG8_LDA(dst, b, h) do { _Pragma("unroll") for (int m = 0; m < 4; ++m) _Pragma("unroll") for (int k = 0; k < 2; ++k) dst[m][k] = *(const LAS bf16x8*)(lds + PG8_SA(b, h) + aoff + m * 2048 + k * 1024); } while (0)
#define PG8_LDB(dst, b, h) do { _Pragma("unroll") for (int n = 0; n < 2; ++n) _Pragma("unroll") for (int k = 0; k < 2; ++k) dst[n][k] = *(const LAS bf16x8*)(lds + PG8_SB(b, h) + boff + n * 2048 + k * 1024); } while (0)
#define PG8_MMA(ai, bj, At, Bt) do { __builtin_amdgcn_s_setprio(1); _Pragma("unroll") for (int m = 0; m < 4; ++m) _Pragma("unroll") for (int n = 0; n < 2; ++n) _Pragma("unroll") for (int k = 0; k < 2; ++k) \
        acc[ai][bj][m][n] = __builtin_amdgcn_mfma_f32_16x16x32_bf16(Bt[n][k], At[m][k], acc[ai][bj][m][n], 0, 0, 0); __builtin_amdgcn_s_setprio(0); } while (0)
#define PG8_WAIT_V(n) asm volatile("s_waitcnt vmcnt(" #n ")" ::: "memory")
#define PG8_WAIT_L(n) asm volatile("s_waitcnt lgkmcnt(" #n ")" ::: "memory")
#define PG8_BAR __builtin_amdgcn_s_barrier()
#define PG8_SCHED __builtin_amdgcn_sched_barrier(0)
    Unit cur, nxt; int ui = 0;
    if (!S.next(0, cur)) return;
    f32x4 acc[2][2][4][2];
#pragma unroll
    for (int a = 0; a < 2; ++a)
#pragma unroll
        for (int b = 0; b < 2; ++b)
#pragma unroll
            for (int m = 0; m < 4; ++m)
#pragma unroll
                for (int n = 0; n < 2; ++n) acc[a][b][m][n] = zero4();
    bf16x8 At[4][2], B0[2][2], B1[2][2];
    const char* cA = (const char*)g.A + (size_t)cur.pm * g.tstepA; const char* cB = (const char*)g.Bt + (size_t)cur.pn * g.tstepB;
    PG8_STAGE(PG8_SB(0, 0), cB, voffB); PG8_STAGE(PG8_SB(0, 1), cB + hstepB, voffB); PG8_STAGE(PG8_SA(0, 0), cA, voffA); PG8_STAGE(PG8_SA(0, 1), cA + hstepA, voffA);
    if (wr == 1) PG8_BAR;
    PG8_WAIT_V(2); PG8_BAR;
    PG8_STAGE(PG8_SB(1, 0), cB + kstep, voffB); PG8_STAGE(PG8_SA(1, 0), cA + kstep, voffA); PG8_STAGE(PG8_SB(1, 1), cB + hstepB + kstep, voffB);
    PG8_WAIT_V(6); PG8_BAR;
    for (;;) {
        const bool has_next = S.next(ui + 1, nxt);
        const char* nA = has_next ? (const char*)g.A + (size_t)nxt.pm * g.tstepA : cA; const char* nB = has_next ? (const char*)g.Bt + (size_t)nxt.pn * g.tstepB : cB;
        for (int t = 0; t < nt; t += 2) {
            const bool last = (t == nt - 2);
            const char* a1 = cA + (size_t)(t + 1) * kstep;
            const char* a2 = last ? nA : cA + (size_t)(t + 2) * kstep; const char* b2 = last ? nB : cB + (size_t)(t + 2) * kstep;
            const char* a3 = a2 + kstep; const char* b3 = b2 + kstep;
            PG8_LDB(B0, 0, 0); PG8_LDB(B1, 0, 1); PG8_SCHED; PG8_LDA(At, 0, 0); PG8_STAGE(PG8_SA(1, 1), a1 + hstepA, voffA);
            PG8_WAIT_V(8); PG8_WAIT_L(0); PG8_BAR; PG8_MMA(0, 0, At, B0); PG8_MMA(0, 1, At, B1); PG8_BAR; PG8_SCHED;
            PG8_LDA(At, 0, 1); PG8_STAGE(PG8_SB(0, 0), b2, voffB); PG8_STAGE(PG8_SB(0, 1), b2 + hstepB, voffB); PG8_STAGE(PG8_SA(0, 0), a2, voffA);
            PG8_WAIT_V(8); PG8_WAIT_L(0); PG8_BAR; PG8_MMA(1, 0, At, B0); PG8_MMA(1, 1, At, B1); PG8_BAR; PG8_SCHED;
            PG8_LDB(B0, 1, 0); PG8_LDB(B1, 1, 1); PG8_SCHED; PG8_LDA(At, 1, 0); PG8_STAGE(PG8_SA(0, 1), a2 + hstepA, voffA);
            PG8_WAIT_V(8); PG8_WAIT_L(0); PG8_BAR; PG8_MMA(0, 0, At, B0); PG8_MMA(0, 1, At, B1); PG8_BAR; PG8_SCHED;
            PG8_LDA(At, 1, 1); PG8_STAGE(PG8_SB(1, 0), b3, voffB); PG8_STAGE(PG8_SB(1, 1), b3 + hstepB, voffB); PG8_STAGE(PG8_SA(1, 0), a3, voffA);
            PG8_WAIT_V(8); PG8_WAIT_L(0); PG8_BAR; PG8_MMA(1, 0, At, B0); PG8_MMA(1, 1, At, B1); PG8_BAR; PG8_SCHED;
        }
        if (wr == 0) PG8_BAR;
        E(acc, cur, wr, wc, fr, fq, lds, tid);
        if (!has_next) break;
#pragma unroll
        for (int a = 0; a < 2; ++a)
#pragma unroll
            for (int b = 0; b < 2; ++b)
#pragma unroll
                for (int m = 0; m < 4; ++m)
#pragma unroll
                    for (int n = 0; n < 2; ++n) acc[a][b][m][n] = zero4();
        cur = nxt; cA = nA; cB = nB; ++ui;
        if (wr == 1) PG8_BAR;
    }
    PG8_WAIT_V(0);
    PG8_BAR;
#undef PG8_SA
#undef PG8_SB
#undef PG8_STAGE
#undef PG8_LDA
#undef PG8_LDB
#undef PG8_MMA
#undef PG8_WAIT_V
#undef PG8_WAIT_L
#undef PG8_BAR
#undef PG8_SCHED
}

__device__ __forceinline__ unsigned f2bf(float f) { unsigned u = __builtin_bit_cast(unsigned, f); return (u + 0x7fffu + ((u >> 16) & 1u)) >> 16; }
__device__ __forceinline__ unsigned pk2(float lo, float hi) { return f2bf(lo) | (f2bf(hi) << 16); }
__device__ __forceinline__ float wave_sum(float v) {
#pragma unroll
    for (int o = 1; o < 64; o <<= 1) v += __shfl_xor(v, o);
    return v;
}
__device__ __forceinline__ void p0_transpose_item(const float* W, int K, int N, bf16_t* WT, LAS float* scr, int item, int lane) {
    const int nblk = N / 32, kb = item / nblk, nb = item % nblk, k0 = 64 * kb, n0 = 32 * nb;
    float tv[32];
#pragma unroll
    for (int i = 0; i < 32; ++i) { const int kk = 2 * i + (lane >> 5); tv[i] = W[(size_t)(k0 + kk) * N + n0 + (lane & 31)]; }
#pragma unroll
    for (int i = 0; i < 32; ++i) { const int kk = 2 * i + (lane >> 5); scr[kk * 33 + (lane & 31)] = tv[i]; }
    asm volatile("s_waitcnt lgkmcnt(0)" ::: "memory");
    const int c = lane & 7;
#pragma unroll
    for (int jx = 0; jx < 4; ++jx) { const int n = (lane >> 3) + 8 * jx; const LAS float* s = scr + (8 * c) * 33 + n;
        u32x4 o; o.x = pk2(s[0 * 33], s[1 * 33]); o.y = pk2(s[2 * 33], s[3 * 33]); o.z = pk2(s[4 * 33], s[5 * 33]); o.w = pk2(s[6 * 33], s[7 * 33]);
        *(u32x4*)(WT + (size_t)(n0 + n) * K + k0 + 8 * c) = o; }
    asm volatile("s_waitcnt lgkmcnt(0)" ::: "memory");
}

#define XB_TMO      128
#define XB_XCNT(j)  (256  + 64 * (j))
#define XB_XSUB(j)  (1280 + 64 * (j))
#define XB_XGEN(j)  (2304 + 64 * (j))
#define XB_TOP      3328
#define XB_TOPGEN   3392
#define XB_SPIN_CAP (1u << 18)
__device__ __forceinline__ unsigned xb_ld(unsigned* p)              { return __hip_atomic_load(p, __ATOMIC_RELAXED, __HIP_MEMORY_SCOPE_AGENT); }
__device__ __forceinline__ unsigned xb_add(unsigned* p, unsigned v) { return __hip_atomic_fetch_add(p, v, __ATOMIC_RELAXED, __HIP_MEMORY_SCOPE_AGENT); }
__device__ __forceinline__ unsigned xb_xcc_id() { return (unsigned)__builtin_amdgcn_s_getreg((3 << 11) | 20) & 0xFu; }
#define XB_SPIN(cond, bar) do { unsigned _sp = 0; while (cond) { __builtin_amdgcn_s_sleep(1); \
    if ((++_sp & 255u) == 0u) { if (xb_ld(&(bar)[XB_TMO])) break; if (_sp > XB_SPIN_CAP) { atomicAdd(&(bar)[XB_TMO], 1u); break; } } } } while (0)
struct XcdBarrier { unsigned* bar; unsigned x; volatile LAS unsigned* st; };
__device__ __forceinline__ XcdBarrier xcd_barrier_post(unsigned* bar, volatile LAS unsigned* st) {
    XcdBarrier b; b.bar = bar; b.x = xb_xcc_id(); b.st = st;
    if (threadIdx.x == 0) (void)xb_add(&bar[XB_XCNT(b.x)], 1u);
    return b;
}
__device__ __forceinline__ void xcd_barrier_complete(unsigned* bar, unsigned x, unsigned& nloc, unsigned& nx) {
    const unsigned G = gridDim.x * gridDim.y * gridDim.z;
    unsigned sum, cnt, mine, sp = 0u;
    for (;;) {
        sum = 0u; cnt = 0u; mine = 0u;
#pragma unroll
        for (unsigned j = 0; j < 16; ++j) { const unsigned c = xb_ld(&bar[XB_XCNT(j)]); sum += c; cnt += (c > 0u) ? 1u : 0u; mine = (j == x) ? c : mine; }
        if (sum == G) break;
        __builtin_amdgcn_s_sleep(1);
        if ((++sp & 255u) == 0u) { if (xb_ld(&bar[XB_TMO])) break; if (sp > XB_SPIN_CAP) { atomicAdd(&bar[XB_TMO], 1u); break; } }
    }
    nloc = mine > 0u ? mine : 1u; nx = cnt > 0u ? cnt : 1u;
}
__device__ __forceinline__ void xcd_barrier(const XcdBarrier& b) {
    asm volatile("s_waitcnt vmcnt(0)" ::: "memory");
    __syncthreads();
    if (threadIdx.x == 0) {
        unsigned* bar = b.bar;
        __builtin_amdgcn_s_waitcnt(0);
        unsigned nloc = b.st[0], nx = b.st[1];
        if (nloc == 0u) { xcd_barrier_complete(bar, b.x, nloc, nx); b.st[0] = nloc; b.st[1] = nx; }
        const unsigned old = xb_add(&bar[XB_XSUB(b.x)], 1u);
        const unsigned gen = old / nloc;
        if (old + 1u == (gen + 1u) * nloc) {
            __builtin_amdgcn_fence(__ATOMIC_RELEASE, "agent");
            asm volatile("s_waitcnt vmcnt(0)" ::: "memory");
            const unsigned og = xb_add(&bar[XB_TOP], 1u);
            const unsigned tg = og / nx;
            if (og + 1u == (tg + 1u) * nx) xb_add(&bar[XB_TOPGEN], 1u);
            else XB_SPIN(xb_ld(&bar[XB_TOPGEN]) == tg, bar);
            __builtin_amdgcn_fence(__ATOMIC_ACQUIRE, "agent");
            xb_add(&bar[XB_XGEN(b.x)], 1u);
            asm volatile("s_waitcnt vmcnt(0)" ::: "memory");
        } else {
            XB_SPIN(xb_ld(&bar[XB_XGEN(b.x)]) == gen, bar);
            __builtin_amdgcn_fence(__ATOMIC_ACQUIRE, "agent");
            asm volatile("s_waitcnt vmcnt(0)" ::: "memory");
        }
    }
    __syncthreads();
}

struct Args { const float* in[16]; float* out; unsigned char* ws; int ph_lo, ph_hi; };

__device__ __forceinline__ void norm_rows_bf16(const float* X, bf16_t* H, const float* gam, const float* modl, int gw, int NGW, int lane) {
    for (int m0 = gw * 4; m0 < MT; m0 += NGW * 4) {
        const int b = m0 >> 13;
        f32x4 v[4][4]; float ss[4];
#pragma unroll
        for (int r = 0; r < 4; ++r) { const f32x4* xr = (const f32x4*)(X + (size_t)(m0 + r) * DM) + lane;
#pragma unroll
            for (int j = 0; j < 4; ++j) v[r][j] = xr[64 * j]; }
#pragma unroll
        for (int r = 0; r < 4; ++r) { float s = 0.f;
#pragma unroll
            for (int j = 0; j < 4; ++j) s += (v[r][j][0] * v[r][j][0] + v[r][j][1] * v[r][j][1]) + (v[r][j][2] * v[r][j][2] + v[r][j][3] * v[r][j][3]);
            ss[r] = 1.0f / sqrtf(wave_sum(s) * (1.0f / DM) + RMS_EPS); }
        const float* mb = modl + (size_t)b * 3072;
#pragma unroll
        for (int j = 0; j < 4; ++j) { const int col = 256 * j + 4 * lane;
            const f32x4 gg = *(const f32x4*)(gam + col), sh = *(const f32x4*)(mb + col), sc = *(const f32x4*)(mb + 1024 + col);
            const f32x4 mul = gg * (sc + 1.0f);
#pragma unroll
            for (int r = 0; r < 4; ++r) { const f32x4 o = v[r][j] * ss[r] * mul + sh;
                u32x2 w; w.x = pk2(o[0], o[1]); w.y = pk2(o[2], o[3]);
                *(u32x2*)(H + (size_t)(m0 + r) * DM + col) = w; } }
    }
}

__global__ void __launch_bounds__(512, 2) fwd_megakernel(Args args) {
    extern __shared__ __attribute__((aligned(16))) unsigned char lds_raw[];
    LAS unsigned char* lds = (LAS unsigned char*)lds_raw;
    cg::grid_group grid = cg::this_grid();
    const int tid = threadIdx.x, lane = tid & 63, wave = __builtin_amdgcn_readfirstlane(tid >> 6);
    const int G = gridDim.x, bx = blockIdx.x, gw = bx * 8 + wave, NGW = G * 8;
    unsigned char* ws = args.ws;
    const float* x = args.in[0]; const float* cvec = args.in[1]; const float* mod_w = args.in[2]; const float* mod_b = args.in[3]; const float* norm_g = args.in[4];
    const float* a_w_in = args.in[5]; const float* a_conv_w = args.in[6]; const float* a_conv_b = args.in[7]; const float* a_w_out = args.in[8];
    const float* b_w_in = args.in[9]; const float* b_ln_g = args.in[10]; const float* b_ln_b = args.in[11]; const float* b_w_s = args.in[12]; const float* b_b_s = args.in[13];
    const float* b_w_out = args.in[14]; const float* final_g = args.in[15];
    float* out = args.out;
    float* MOD = (float*)(ws + WS_MOD); f32x2* PART = (f32x2*)(ws + WS_PART);
    float* HG = (float*)(ws + WS_HG); float* GG = (float*)(ws + WS_GG); float* PC = (float*)(ws + WS_PC);
    bf16_t* WSb = (bf16_t*)(ws + WS_WS); bf16_t* W1t = (bf16_t*)(ws + WS_W1); bf16_t* W2t = (bf16_t*)(ws + WS_W2); bf16_t* W3t = (bf16_t*)(ws + WS_W3); bf16_t* W4t = (bf16_t*)(ws + WS_W4);
    bf16_t* H = (bf16_t*)(ws + WS_H); bf16_t* Y = (bf16_t*)(ws + WS_Y); bf16_t* VT = (bf16_t*)(ws + WS_VT);
    const int lo = args.ph_lo, hi = args.ph_hi;
    if (lo < 0) grid.sync();
#define IN(k) (lo <= (k) && (k) < hi)
#define SEAM(k) do { if (IN(k) && IN((k) + 1)) xcd_barrier(xbar); } while (0)
    volatile LAS unsigned* MISC = (volatile LAS unsigned*)(lds + EPI_OFF + 8192);
    if (tid < 2) MISC[tid] = 0u;
    __syncthreads();
    XcdBarrier xbar = xcd_barrier_post((unsigned*)(ws + WS_CTL) + 4096, MISC);

    if (IN(0)) {
        LAS float* sc = (LAS float*)lds;
        for (int it = bx; it < 384; it += G) {
            const int l = it / 192, r = it % 192, ks = r / 6, cgp = r % 6;
            __syncthreads();
            if (tid < 128) { const int b = tid >> 5, kk = tid & 31; const float cv = cvec[b * DM + ks * 32 + kk]; sc[tid] = cv / (1.0f + __expf(-cv)); }
            __syncthreads();
            const int n = cgp * 512 + tid;
            const float* w = mod_w + ((size_t)l * DM + ks * 32) * 3072 + n;
            float wv[32];
#pragma unroll
            for (int kk = 0; kk < 32; ++kk) wv[kk] = w[(size_t)kk * 3072];
            float a0 = 0.f, a1 = 0.f, a2 = 0.f, a3 = 0.f;
#pragma unroll
            for (int kk = 0; kk < 32; ++kk) { a0 += sc[kk] * wv[kk]; a1 += sc[32 + kk] * wv[kk]; a2 += sc[64 + kk] * wv[kk]; a3 += sc[96 + kk] * wv[kk]; }
            if (ks == 0) { const float bv = mod_b[l * 3072 + n]; a0 += bv; a1 += bv; a2 += bv; a3 += bv; }
            float* mp = MOD + (size_t)l * 4 * 3072 + n;
            atomicAdd(mp, a0); atomicAdd(mp + 3072, a1); atomicAdd(mp + 2 * 3072, a2); atomicAdd(mp + 3 * 3072, a3);
        }
        __syncthreads();
        LAS float* scr = (LAS float*)(lds + wave * 16384);
        constexpr int I1 = (DM / 64) * (4 * DE / 32), I2 = (DE / 64) * (DM / 32), I3 = (DM / 64) * (3 * DE / 32), I4 = I2;
        for (int it = gw; it < I1 + I2 + I3 + I4; it += NGW) {
            int r = it;
            if (r < I1) { p0_transpose_item(a_w_in, DM, 4 * DE, W1t, scr, r, lane); continue; } r -= I1;
            if (r < I2) { p0_transpose_item(a_w_out, DE, DM, W2t, scr, r, lane); continue; } r -= I2;
            if (r < I3) { p0_transpose_item(b_w_in, DM, 3 * DE, W3t, scr, r, lane); continue; } r -= I3;
            p0_transpose_item(b_w_out, DE, DM, W4t, scr, r, lane);
        }
        for (int i = bx * 512 + tid; i < 8 * 128 * 128; i += G * 512) { const int s = i & 127, t = (i >> 7) & 127; WSb[i] = (bf16_t)f2bf(s <= t ? b_w_s[i] : 0.0f); }
    }
    SEAM(0);
    if (IN(1)) norm_rows_bf16(x, H, norm_g, MOD, gw, NGW, lane);
    SEAM(1);
    if (IN(2)) {
        GemmDesc g{H, W1t, DM, (size_t)256 * DM * 2, (size_t)128 * DM * 2, (size_t)64 * DM * 2, (size_t)4096 * DM * 2, MT / 256, 32, DM, DM};
        StaticOrder S; S.init(g.nM, g.nN, G, bx);
        EpiConv E{Y, a_conv_w, a_conv_b, HG, GG, PC};
        gemm_phase<EpiConv>(lds, g, S, E);
    }
    if (IN(2) && IN(4)) xcd_barrier(xbar);
    if (IN(4)) {
        GemmDesc g{Y, W2t, DE, (size_t)256 * YP * 2, (size_t)128 * YP * 2, (size_t)256 * DE * 2, (size_t)128 * DE * 2, MT / 256, 4, YP, DE};
        StaticOrder S; S.init(g.nM, g.nN, G, bx);
        { Unit fu;
          for (int ui = 0; S.next(ui, fu); ++ui) {
            const int pm = fu.pm; if ((pm & 31) == 0) continue;
            for (int it = tid; it < 1024; it += 512) {
                const int i = it >> 9, j = (it & 511) * 4;
                const f32x4 g = *(const f32x4*)(GG + ((size_t)(pm * 2 + i)) * 2048 + j), pc = *(const f32x4*)(PC + ((size_t)(pm * 2 + i)) * 2048 + j);
                const f32x4 c15 = *(const f32x4*)(HG + ((size_t)((pm - 1) * 2 + 1)) * 2048 + j), c14 = *(const f32x4*)(HG + ((size_t)((pm - 1) * 2 + 0)) * 2048 + j);
                const f32x4 w0 = *(const f32x4*)(a_conv_w + j), w1 = *(const f32x4*)(a_conv_w + 2048 + j);
                const f32x4 add = (i == 0) ? (w1 * c15 + w0 * c14) : (w0 * c15);
                const f32x4 yv = g * (pc + add);
                u32x2 w; w.x = pk2(yv[0], yv[1]); w.y = pk2(yv[2], yv[3]);
                *(u32x2*)(Y + ((size_t)pm * 256 + i) * YP + j) = w;
            }
          }
          asm volatile("s_waitcnt vmcnt(0)" ::: "memory"); __syncthreads(); }
        EpiResNorm<0> E{x, out, H, MOD + 2048, norm_g + DM, MOD + 4 * 3072, (float*)(ws + WS_XS), (unsigned*)(ws + WS_CTL) + 8192, (bf16_t*)(ws + WS_X1)};
        gemm_phase<EpiResNorm<0>>(lds, g, S, E);
    }
    if (IN(4) && IN(6)) xcd_barrier(xbar);
    if (IN(6)) {
        GemmDesc g{W3t + (size_t)2048 * DM, H, DM, (size_t)256 * DM * 2, (size_t)128 * DM * 2, (size_t)256 * DM * 2, (size_t)128 * DM * 2, 8, MT / 256, DM, DM};
        StaticOrder S; S.init(g.nM, g.nN, G, bx);
        EpiV E{VT, PART};
        gemm_phase<EpiV>(lds, g, S, E);
    }
    SEAM(6);
    if (IN(7)) {
        GemmDesc g{H, W3t, DM, (size_t)256 * DM * 2, (size_t)128 * DM * 2, (size_t)128 * DM * 2, (size_t)4096 * DM * 2, MT / 256, 16, DM, DM};
        StaticOrder S; S.init(g.nM, g.nN, G, bx);
        EpiMix E{Y, VT, WSb, PART, b_ln_g, b_ln_b, b_b_s};
        gemm_phase<EpiMix>(lds, g, S, E);
    }
    SEAM(7);
    if (IN(8)) {
        GemmDesc g{Y, W4t, DE, (size_t)256 * YP * 2, (size_t)128 * YP * 2, (size_t)256 * DE * 2, (size_t)128 * DE * 2, MT / 256, 4, YP, DE};
        StaticOrder S; S.init(g.nM, g.nN, G, bx);
        EpiResNorm<1> E{out, out, nullptr, MOD + 4 * 3072 + 2048, final_g, nullptr, (float*)(ws + WS_XS) + 128 * 4 * 256, (unsigned*)(ws + WS_CTL) + 8192 + 128 * 64, (bf16_t*)(ws + WS_X1)};
        gemm_phase<EpiResNorm<1>>(lds, g, S, E);
    }
#undef IN
#undef SEAM
}

#ifndef MK_MULTI
#define MK_MULTI 0
#endif
extern "C" void kernel_launch(void* const* d_in, const int* in_sizes, int n_in, void* d_out, int out_size, void* d_ws, size_t ws_size, hipStream_t stream) {
    static int grid = 0;
    if (grid == 0) {
        if (n_in != 16 || out_size != MT * DM || ws_size < WS_END) { fprintf(stderr, "kernel_launch: unexpected shapes (n_in %d out %d ws %zu)\n", n_in, out_size, ws_size); grid = -1; return; }
        int dev = 0, cus = 0, per_cu = 0;
        hipGetDevice(&dev); hipDeviceGetAttribute(&cus, hipDeviceAttributeMultiprocessorCount, dev);
        if (hipFuncSetAttribute((const void*)fwd_megakernel, hipFuncAttributeMaxDynamicSharedMemorySize, LDS_BYTES) != hipSuccess) { fprintf(stderr, "kernel_launch: hipFuncSetAttribute failed\n"); grid = -1; return; }
        if (hipOccupancyMaxActiveBlocksPerMultiprocessor(&per_cu, (const void*)fwd_megakernel, 512, LDS_BYTES) != hipSuccess || per_cu < 1) { fprintf(stderr, "kernel_launch: occupancy query says %d\n", per_cu); per_cu = 1; }
        (void)hipGetLastError();
        grid = cus * per_cu;
    }
    if (grid < 0) return;
    hipMemsetAsync((char*)d_ws + WS_CTL, 0, CTL_ZERO_BYTES, stream);
    Args a{};
    for (int i = 0; i < 16; ++i) a.in[i] = (const float*)d_in[i];
    a.out = (float*)d_out; a.ws = (unsigned char*)d_ws;
#if MK_MULTI
    for (int p = 0; p < 10; ++p) { a.ph_lo = p; a.ph_hi = p + 1; hipLaunchKernelGGL(fwd_megakernel, dim3(grid), dim3(512), LDS_BYTES, stream, a); }
#else
    a.ph_lo = 0; a.ph_hi = 10;
    void* kargs[] = {&a};
    hipError_t e = hipLaunchCooperativeKernel((const void*)fwd_megakernel, dim3(grid), dim3(512), kargs, LDS_BYTES, stream);
    if (e != hipSuccess) fprintf(stderr, "cooperative launch failed: %s (grid %d)\n", hipGetErrorString(e), grid);
#endif
}
```

```cpp
#include <hip/hip_runtime.h>
#include <hip/hip_cooperative_groups.h>
#include <cstdio>
#include <cstdint>
namespace cg = cooperative_groups;

#define LAS __attribute__((address_space(3)))
typedef unsigned short bf16_t;
typedef short bf16x8 __attribute__((ext_vector_type(8)));
typedef float f32x4 __attribute__((ext_vector_type(4)));
typedef float f32x2 __attribute__((ext_vector_type(2)));
typedef unsigned u32x4 __attribute__((ext_vector_type(4)));
typedef unsigned u32x2 __attribute__((ext_vector_type(2)));

constexpr int DM = 1024, NB = 4, SEQ = 8192, DE = 2048, MT = NB * SEQ;
constexpr float RMS_EPS = 1e-6f, LN_EPS = 1e-5f;
constexpr int YP = DE;

constexpr size_t MiB = 1u << 20;
constexpr size_t WS_CTL = 0, CTL_ZERO_BYTES = 256 * 1024;
constexpr size_t WS_MOD = 128 * 1024;
constexpr size_t WS_PART = 46 * MiB;
constexpr size_t WS_XS = 2 * MiB;
constexpr size_t WS_HG = 3 * MiB, WS_GG = 5 * MiB, WS_PC = 7 * MiB;
constexpr size_t WS_WS = 9 * MiB;
constexpr size_t WS_W1 = 10 * MiB;
constexpr size_t WS_W2 = 26 * MiB;
constexpr size_t WS_W3 = 30 * MiB;
constexpr size_t WS_W4 = 42 * MiB;
constexpr size_t WS_H = 48 * MiB;
constexpr size_t WS_Y = 112 * MiB;
constexpr size_t WS_VT = 248 * MiB;
constexpr size_t WS_X1 = 376 * MiB;
constexpr size_t WS_END = 440 * MiB;

constexpr int STAGE_BYTES = 131072, EPI_OFF = 131072, LDS_BYTES = 147456;

constexpr int BM = 256, BK = 64, HALF = 128, HTB = HALF * BK * 2, NXCD = 8, WGM = 8;
__host__ __device__ __forceinline__ int lds_byte(int r, int c) { const int st = (r >> 4) * 2 + (c >> 5), rr = r & 15, cc = c & 31, ob = rr * 64 + cc * 2; return st * 1024 + (ob ^ (((ob >> 9) & 1) << 5)); }
__host__ __device__ __forceinline__ void stage_rc(int b, int& R, int& C) { const int st = b / 1024, sb = b % 1024, swz = sb ^ (((sb >> 9) & 1) << 5); R = (st >> 1) * 16 + swz / 64; C = (st & 1) * 32 + (swz % 64) / 2; }
__host__ __device__ __forceinline__ int perm32(int rho) { const int n = rho >> 4, i = rho & 15; return 8 * (i >> 2) + 4 * n + (i & 3); }

__host__ __device__ __forceinline__ size_t tiled_elem(int row, int col, int nKt) { return (size_t)((row >> 7) * nKt + (col >> 6)) * 8192 + (size_t)(lds_byte(row & 127, col & 63) >> 1); }
struct Unit { int pm, pn; };
struct GemmDesc { const bf16_t* A; const bf16_t* Bt; int K; size_t tstepA, hstepA, tstepB, hstepB; int nM, nN; int pnHalf; };

struct StaticOrder {
    int nM, nN, nwg, G, c;
    __device__ void init(int nM_, int nN_, int G_, int c_) { nM = nM_; nN = nN_; nwg = nM * nN; G = G_; c = c_; }
    __device__ bool next(int i, Unit& u) const {
        const long L = (long)i * G + c; if (L >= nwg) return false;
        int wgid = (int)L; { const int q = nwg / NXCD, r = nwg % NXCD, xcd = wgid % NXCD, off = wgid / NXCD; wgid = (xcd < r ? xcd * (q + 1) : r * (q + 1) + (xcd - r) * q) + off; }
        const int nig = WGM * nN, gid = wgid / nig, fm = gid * WGM, gsz = (nM - fm) < WGM ? (nM - fm) : WGM;
        u.pm = fm + ((wgid % nig) % gsz); u.pn = (wgid % nig) / gsz; return true;
    }
};

__device__ __forceinline__ unsigned cvt_pk_bf16(float lo, float hi) { unsigned r; asm volatile("v_cvt_pk_bf16_f32 %0, %1, %2" : "=v"(r) : "v"(lo), "v"(hi)); return r; }
__device__ __forceinline__ f32x2 gelu_pk(f32x2 v) {
    const f32x2 av = __builtin_elementwise_abs(v), d = av * 0.2316418882f + 1.0f;
    f32x2 t; t.x = __builtin_amdgcn_rcpf(d.x); t.y = __builtin_amdgcn_rcpf(d.y);
    f32x2 q = t * 0.5307027145f + (-0.7265760135f); q = q * t + 0.7107068705f; q = q * t + (-0.142248368f); q = q * t + 0.127414796f; q = q * t;
    const f32x2 s = (v * v) * (-0.72134752044f);
    f32x2 e; e.x = __builtin_amdgcn_exp2f(s.x); e.y = __builtin_amdgcn_exp2f(s.y);
    const f32x2 c = 0.5f - q * e;
    return av * c + v * 0.5f;
}
__device__ __forceinline__ f32x4 gelu4(f32x4 v) { const f32x2 a = gelu_pk((f32x2){v[0], v[1]}), b = gelu_pk((f32x2){v[2], v[3]}); return (f32x4){a.x, a.y, b.x, b.y}; }
__device__ __forceinline__ float silu1(float z) { return z * __builtin_amdgcn_rcpf(1.0f + __builtin_amdgcn_exp2f(-1.4426950408889634f * z)); }
__device__ __forceinline__ f32x2 silu2(f32x2 z) {
    const f32x2 a = z * (-1.4426950408889634f);
    f32x2 e; e.x = __builtin_amdgcn_exp2f(a.x); e.y = __builtin_amdgcn_exp2f(a.y);
    const f32x2 d = e + 1.0f;
    f32x2 r; r.x = __builtin_amdgcn_rcpf(d.x); r.y = __builtin_amdgcn_rcpf(d.y);
    return z * r;
}
__device__ __forceinline__ f32x4 silu4(f32x4 z) { const f32x2 a = silu2((f32x2){z[0], z[1]}), b = silu2((f32x2){z[2], z[3]}); return (f32x4){a.x, a.y, b.x, b.y}; }
#define EPI_BARRIER() do { asm volatile("s_waitcnt lgkmcnt(0)" ::: "memory"); __builtin_amdgcn_s_barrier(); asm volatile("" ::: "memory"); } while (0)


struct EpiConv {
    static __host__ __device__ __forceinline__ unsigned boff(int R, int C, int nKt) { return (unsigned)(((R >> 4) & 1) * 16 * nKt) * 16384u + (unsigned)(R >> 5) * 2048u + (unsigned)lds_byte(R & 15, C); }
    bf16_t* Y; const float* cw; const float* cb; float* HG; float* GG; float* PC;
    __device__ __forceinline__ void operator()(f32x4 (&acc)[2][2][4][2], const Unit& u, int wr, int wc, int fr, int fq, LAS unsigned char* lds, int tid) const {
        LAS float* halo = (LAS float*)(lds + EPI_OFF);
        const int jl = 16 * wc + 4 * fq, j = 64 * u.pn + jl;
#pragma unroll
        for (int ai = 0; ai < 2; ++ai)
#pragma unroll
            for (int m = 0; m < 4; ++m) {
                const f32x4 Bg = acc[ai][0][m][0], Cg = acc[ai][0][m][1], Xi = acc[ai][1][m][0], Z = acc[ai][1][m][1];
                const f32x4 cx = Cg * Xi, g = silu4(Z) * Bg;
                acc[ai][0][m][1] = cx; acc[ai][1][m][1] = g;
                const int G = ai * 8 + wr * 4 + m;
                if (fr >= 14) {
                    *(LAS f32x4*)(halo + (G * 2 + (fr - 14)) * 64 + jl) = cx;
                    if (G == 15) *(f32x4*)(HG + ((size_t)(u.pm * 2 + (fr - 14))) * 2048 + j) = cx;
                }
            }
        EPI_BARRIER();
        const f32x4 w0 = *(const f32x4*)(cw + j), w1 = *(const f32x4*)(cw + 2048 + j), w2 = *(const f32x4*)(cw + 4096 + j), cbv = *(const f32x4*)(cb + j);
#pragma unroll
        for (int ai = 0; ai < 2; ++ai)
#pragma unroll
            for (int m = 0; m < 4; ++m) {
                const int G = ai * 8 + wr * 4 + m;
                const f32x4 cx = acc[ai][0][m][1], g = acc[ai][1][m][1];
                f32x4 h1 = (f32x4){0.f, 0.f, 0.f, 0.f}, hB = h1;
                if (G > 0) { h1 = *(const LAS f32x4*)(halo + ((G - 1) * 2 + 1) * 64 + jl); hB = *(const LAS f32x4*)(halo + ((G - 1) * 2 + (fr < 1 ? 0 : 1)) * 64 + jl); }
                f32x4 p1, p2;
#pragma unroll
                for (int e = 0; e < 4; ++e) { p1[e] = __shfl_up(cx[e], 1, 16); p2[e] = __shfl_up(cx[e], 2, 16); }
                if (fr < 1) p1 = h1;
                if (fr < 2) p2 = hB;
                const f32x4 pc = cbv + w2 * cx + w1 * p1 + w0 * p2, yv = g * pc;
                const size_t row = (size_t)u.pm * 256 + 16 * G + fr;
                u32x2 w; w.x = cvt_pk_bf16(yv[0], yv[1]); w.y = cvt_pk_bf16(yv[2], yv[3]);
                *(u32x2*)(Y + tiled_elem((int)row, j, DE / 64)) = w;
                if (G == 0 && fr < 2) { *(f32x4*)(GG + ((size_t)(u.pm * 2 + fr)) * 2048 + j) = g; *(f32x4*)(PC + ((size_t)(u.pm * 2 + fr)) * 2048 + j) = pc; }
            }
    }
};

struct EpiRes {
    static __host__ __device__ __forceinline__ unsigned boff(int R, int C, int nKt) { return (unsigned)lds_byte(R, C); }
    const float* xin; float* out; const float* gate;
    __device__ __forceinline__ void operator()(f32x4 (&acc)[2][2][4][2], const Unit& u, int wr, int wc, int fr, int fq, LAS unsigned char* lds, int tid) const {
        const int row0 = u.pm * BM + wr * 64 + fr, col0 = u.pn * BM + wc * 32 + 4 * fq;
        const float* gp = gate + (size_t)(u.pm >> 5) * 3072 + col0;
        f32x4 gv[2][2];
#pragma unroll
        for (int bj = 0; bj < 2; ++bj)
#pragma unroll
            for (int n = 0; n < 2; ++n) gv[bj][n] = *(const f32x4*)(gp + bj * HALF + n * 16);
#pragma unroll
        for (int ai = 0; ai < 2; ++ai)
#pragma unroll
            for (int m = 0; m < 4; ++m) { const size_t off = (size_t)(row0 + ai * HALF + m * 16) * DM + col0;
#pragma unroll
                for (int bj = 0; bj < 2; ++bj)
#pragma unroll
                    for (int n = 0; n < 2; ++n) { const f32x4 xv = *(const f32x4*)(xin + off + bj * HALF + n * 16); *(f32x4*)(out + off + bj * HALF + n * 16) = xv + gv[bj][n] * acc[ai][bj][m][n]; }
                if (m & 1) asm volatile("" ::: "memory"); }
    }
};

template <int MODE> struct EpiResNorm {
    static __host__ __device__ __forceinline__ unsigned boff(int R, int C, int nKt) { return (unsigned)lds_byte((R & ~31) + perm32(R & 31), C); }
    const float* xin; float* out; bf16_t* Hn; const float* gate; const float* gam; const float* modl; float* XS; unsigned* cnt; bf16_t* X1;
    __device__ __forceinline__ void operator()(f32x4 (&acc)[2][2][4][2], const Unit& u_, int wr_, int wc_, int fr_, int fq_, LAS unsigned char* lds, int tid_) const {
        Unit u; u.pm = u_.pm; u.pn = u_.pn; asm volatile("" : "+s"(u.pm), "+s"(u.pn));
        int tid = tid_; asm volatile("" : "+v"(tid));
        const int wid = __builtin_amdgcn_readfirstlane(tid >> 6), wr = wid >> 2, wc = wid & 3, fr = tid & 15, fq = (tid >> 4) & 3;
        LAS float* P = (LAS float*)(lds + EPI_OFF);
        LAS float* S = (LAS float*)(lds + EPI_OFF + 4096);
        const int b = u.pm >> 5;
        const int row0 = u.pm * BM + wr * 64 + fr, col0 = u.pn * BM + wc * 32 + 8 * fq;
        {
            f32x4 gv[2][2];
#pragma unroll
            for (int bj = 0; bj < 2; ++bj)
#pragma unroll
                for (int n = 0; n < 2; ++n) gv[bj][n] = *(const f32x4*)(gate + (size_t)b * 3072 + col0 + bj * HALF + 4 * n);
            if (MODE == 0) {
#pragma unroll
            for (int ai = 0; ai < 2; ++ai) {
                f32x4 xt[4][2][2];
#pragma unroll
                for (int m = 0; m < 4; ++m) { const unsigned off = (unsigned)(row0 + ai * HALF + m * 16) * DM + col0;
#pragma unroll
                    for (int bj = 0; bj < 2; ++bj)
#pragma unroll
                        for (int n = 0; n < 2; ++n) xt[m][bj][n] = *(const f32x4*)(xin + off + bj * HALF + 4 * n); }
#pragma unroll
                for (int m = 0; m < 4; ++m) {
#pragma unroll
                    for (int bj = 0; bj < 2; ++bj)
#pragma unroll
                        for (int n = 0; n < 2; ++n) acc[ai][bj][m][n] = xt[m][bj][n] + gv[bj][n] * acc[ai][bj][m][n];
                    asm volatile("" : "+v"(acc[ai][0][m][0]), "+v"(acc[ai][0][m][1]), "+v"(acc[ai][1][m][0]), "+v"(acc[ai][1][m][1]));
                }
                asm volatile("" ::: "memory"); __builtin_amdgcn_sched_barrier(0);
            }
            } else {
#pragma unroll
            for (int ai = 0; ai < 2; ++ai) {
                u32x4 xb[4][2];
#pragma unroll
                for (int m = 0; m < 4; ++m) { const unsigned off = (unsigned)(row0 + ai * HALF + m * 16) * DM + col0;
#pragma unroll
                    for (int bj = 0; bj < 2; ++bj) xb[m][bj] = *(const u32x4*)(X1 + off + bj * HALF); }
#pragma unroll
                for (int m = 0; m < 4; ++m) {
#pragma unroll
                    for (int bj = 0; bj < 2; ++bj) { const u32x4 w = xb[m][bj];
                        const f32x4 xa = (f32x4){__uint_as_float(w.x << 16), __uint_as_float(w.x & 0xffff0000u), __uint_as_float(w.y << 16), __uint_as_float(w.y & 0xffff0000u)};
                        const f32x4 xc = (f32x4){__uint_as_float(w.z << 16), __uint_as_float(w.z & 0xffff0000u), __uint_as_float(w.w << 16), __uint_as_float(w.w & 0xffff0000u)};
                        acc[ai][bj][m][0] = xa + gv[bj][0] * acc[ai][bj][m][0]; acc[ai][bj][m][1] = xc + gv[bj][1] * acc[ai][bj][m][1]; }
                    asm volatile("" : "+v"(acc[ai][0][m][0]), "+v"(acc[ai][0][m][1]), "+v"(acc[ai][1][m][0]), "+v"(acc[ai][1][m][1]));
                }
                asm volatile("" ::: "memory"); __builtin_amdgcn_sched_barrier(0);
            }
            }
        }
#pragma unroll
        for (int ai = 0; ai < 2; ++ai)
#pragma unroll
            for (int m = 0; m < 4; ++m) { float ss = 0.f;
#pragma unroll
                for (int bj = 0; bj < 2; ++bj)
#pragma unroll
                    for (int n = 0; n < 2; ++n) { const f32x4 v = acc[ai][bj][m][n]; ss += (v[0] * v[0] + v[1] * v[1]) + (v[2] * v[2] + v[3] * v[3]); }
                ss += __shfl_xor(ss, 16); ss += __shfl_xor(ss, 32);
                if (fq == 0) P[(ai * HALF + wr * 64 + m * 16 + fr) * 4 + wc] = ss; }
        EPI_BARRIER();
        if (wid < 4) {
            const f32x4 p = *(const LAS f32x4*)(P + tid * 4);
            __hip_atomic_store(XS + ((size_t)(u.pm * 4 + u.pn)) * 256 + tid, (p[0] + p[1]) + (p[2] + p[3]), __ATOMIC_RELAXED, __HIP_MEMORY_SCOPE_AGENT);
            asm volatile("s_waitcnt vmcnt(0)" ::: "memory");
            if ((tid & 63) == 0) __hip_atomic_fetch_add(cnt + 64 * u.pm, 1u, __ATOMIC_RELAXED, __HIP_MEMORY_SCOPE_AGENT);
        }
        if (MODE == 0) {
#pragma unroll
            for (int ai = 0; ai < 2; ++ai)
#pragma unroll
                for (int m = 0; m < 4; ++m) { const unsigned off = (unsigned)(row0 + ai * HALF + m * 16) * DM + col0;
#pragma unroll
                    for (int bj = 0; bj < 2; ++bj) { const f32x4 a = acc[ai][bj][m][0], c = acc[ai][bj][m][1];
                        u32x4 w; w.x = cvt_pk_bf16(a[0], a[1]); w.y = cvt_pk_bf16(a[2], a[3]); w.z = cvt_pk_bf16(c[0], c[1]); w.w = cvt_pk_bf16(c[2], c[3]);
                        *(u32x4*)(X1 + off + bj * HALF) = w; } }
        }
        if (wid == 0) {
            unsigned sp = 0;
            while ((unsigned)__builtin_amdgcn_readfirstlane(__hip_atomic_load(cnt + 64 * u.pm, __ATOMIC_RELAXED, __HIP_MEMORY_SCOPE_AGENT)) < 16u) { __builtin_amdgcn_s_sleep(1); if (++sp > (1u << 20)) break; }
            __builtin_amdgcn_fence(__ATOMIC_ACQUIRE, "agent");
            asm volatile("s_waitcnt vmcnt(0)" ::: "memory");
        }
        EPI_BARRIER();
        if (wid < 4) { float t = 0.f;
#pragma unroll
            for (int p = 0; p < 4; ++p) t += __hip_atomic_load(XS + ((size_t)(u.pm * 4 + p)) * 256 + tid, __ATOMIC_RELAXED, __HIP_MEMORY_SCOPE_AGENT);
            S[tid] = 1.0f / sqrtf(t * (1.0f / DM) + RMS_EPS); }
        EPI_BARRIER();
#pragma unroll
        for (int bj = 0; bj < 2; ++bj) {
            f32x4 mul[2], sh[2];
#pragma unroll
            for (int n = 0; n < 2; ++n) { const int c = col0 + bj * HALF + 4 * n; const f32x4 gg = *(const f32x4*)(gam + c);
                if (MODE == 0) { const f32x4 sc = *(const f32x4*)(modl + (size_t)b * 3072 + 1024 + c); mul[n] = gg * (sc + 1.0f); sh[n] = *(const f32x4*)(modl + (size_t)b * 3072 + c); }
                else { mul[n] = gg; sh[n] = (f32x4){0.f, 0.f, 0.f, 0.f}; } }
#pragma unroll
            for (int ai = 0; ai < 2; ++ai)
#pragma unroll
                for (int m = 0; m < 4; ++m) { const int r = ai * HALF + wr * 64 + m * 16 + fr; const float rs = S[r]; const unsigned off = (unsigned)(u.pm * BM + r) * DM + col0 + bj * HALF;
                    const f32x4 o0 = acc[ai][bj][m][0] * rs * mul[0] + sh[0], o1 = acc[ai][bj][m][1] * rs * mul[1] + sh[1];
                    if (MODE == 0) { u32x4 w; w.x = cvt_pk_bf16(o0[0], o0[1]); w.y = cvt_pk_bf16(o0[2], o0[3]); w.z = cvt_pk_bf16(o1[0], o1[1]); w.w = cvt_pk_bf16(o1[2], o1[3]); *(u32x4*)(Hn + tiled_elem(u.pm * BM + r, col0 + bj * HALF, DM / 64)) = w; }
                    else { *(f32x4*)(out + off) = o0; *(f32x4*)(out + off + 4) = o1; } }
            asm volatile("" ::: "memory");
        }
    }
};

__device__ __forceinline__ float row16_sum(float x) {
    x += __builtin_bit_cast(float, __builtin_amdgcn_update_dpp(0, __builtin_bit_cast(int, x), 0x128, 0xf, 0xf, true));
    x += __builtin_bit_cast(float, __builtin_amdgcn_update_dpp(0, __builtin_bit_cast(int, x), 0x124, 0xf, 0xf, true));
    x += __builtin_bit_cast(float, __builtin_amdgcn_update_dpp(0, __builtin_bit_cast(int, x), 0x122, 0xf, 0xf, true));
    x += __builtin_bit_cast(float, __builtin_amdgcn_update_dpp(0, __builtin_bit_cast(int, x), 0x121, 0xf, 0xf, true));
    return x;
}
struct EpiV {
    static __host__ __device__ __forceinline__ unsigned boff(int R, int C, int nKt) { return (unsigned)lds_byte((R & ~31) + perm32(R & 31), C); }
    bf16_t* VT; f32x2* PART;
    __device__ __forceinline__ void operator()(f32x4 (&acc)[2][2][4][2], const Unit& u, int wr, int wc, int fr, int fq, LAS unsigned char* lds, int tid) const {
        LAS float* red = (LAS float*)(lds + EPI_OFF);
#pragma unroll
        for (int bj = 0; bj < 2; ++bj) {
            const int chunk = 2 * u.pn + bj;
            f32x4 s0 = (f32x4){0.f, 0.f, 0.f, 0.f}, s1 = s0, q0 = s0, q1 = s0;
#pragma unroll
            for (int ai = 0; ai < 2; ++ai)
#pragma unroll
                for (int m = 0; m < 4; ++m) {
                    const int f = 256 * u.pm + 128 * ai + 64 * wr + 16 * m + fr;
                    const f32x4 v0 = gelu4(acc[ai][bj][m][0]), v1 = gelu4(acc[ai][bj][m][1]);
                    s0 += v0; s1 += v1; q0 += v0 * v0; q1 += v1 * v1;
                    u32x4 w; w.x = cvt_pk_bf16(v0[0], v0[1]); w.y = cvt_pk_bf16(v0[2], v0[3]); w.z = cvt_pk_bf16(v1[0], v1[1]); w.w = cvt_pk_bf16(v1[2], v1[3]);
                    *(u32x4*)(VT + ((size_t)chunk * 2048 + f) * 128 + 32 * wc + 8 * fq) = w;
                }
#pragma unroll
            for (int e = 0; e < 4; ++e) { s0[e] = row16_sum(s0[e]); s1[e] = row16_sum(s1[e]); q0[e] = row16_sum(q0[e]); q1[e] = row16_sum(q1[e]); }
            if (fr == 0) {
                LAS f32x4* rp = (LAS f32x4*)(red + ((size_t)((wr * 2 + bj) * 128) + 32 * wc + 8 * fq) * 2);
                rp[0] = (f32x4){s0[0], q0[0], s0[1], q0[1]}; rp[1] = (f32x4){s0[2], q0[2], s0[3], q0[3]};
                rp[2] = (f32x4){s1[0], q1[0], s1[1], q1[1]}; rp[3] = (f32x4){s1[2], q1[2], s1[3], q1[3]};
            }
        }
        EPI_BARRIER();
        if (tid < 256) { const LAS f32x2* r2 = (const LAS f32x2*)red; const int bj = tid >> 7, t = tid & 127;
            const f32x2 a = r2[(0 * 2 + bj) * 128 + t], b = r2[(1 * 2 + bj) * 128 + t];
            PART[(size_t)u.pm * MT + 256 * u.pn + tid] = a + b; }
    }
};

struct EpiMix {
    static __host__ __device__ __forceinline__ unsigned boff(int R, int C, int nKt) { return (unsigned)lds_byte((R & ~31) + perm32(R & 31), C); }
    bf16_t* Y; const bf16_t* VT; const bf16_t* WS; const f32x2* stats; const float* lng; const float* lnb; const float* bs;
    __device__ __forceinline__ void operator()(f32x4 (&acc)[2][2][4][2], const Unit& u_, int wr_, int wc_, int fr_, int fq_, LAS unsigned char* lds, int tid_) const {
        Unit u; u.pm = u_.pm; u.pn = u_.pn; asm volatile("" : "+s"(u.pm), "+s"(u.pn));
        int tid = tid_; asm volatile("" : "+v"(tid));
        const int wid = __builtin_amdgcn_readfirstlane(tid >> 6), wr = wid >> 2, wc = wid & 3, fr = tid & 15, fq = (tid >> 4) & 3;
        LAS float* TSA = (LAS float*)(lds + EPI_OFF);
        LAS float* TSB = (LAS float*)(lds + EPI_OFF + 1024);
        const int grp = u.pn >> 1, j0 = 128 * u.pn;
        const int jx = j0 + 32 * wc + 8 * (fr >> 2) + (fr & 3);
        const bf16_t* vbase = VT + ((size_t)(2 * u.pm) * 2048 + jx) * 128 + 8 * fq;
        u32x4 raw[2][4];
#pragma unroll
        for (int n = 0; n < 2; ++n)
#pragma unroll
            for (int k = 0; k < 4; ++k) raw[n][k] = *(const u32x4*)(vbase + n * 512 + 32 * k);
        if (tid < 256) { const unsigned tok = 256u * u.pm + tid; f32x2 sq = stats[tok];
#pragma unroll
            for (int p = 1; p < 8; ++p) sq += stats[(size_t)p * MT + tok];
            const float mean = sq.x * (1.0f / 2048.0f); float var = sq.y * (1.0f / 2048.0f) - mean * mean; var = var < 0.f ? 0.f : var;
            const float rstd = 1.0f / sqrtf(var + LN_EPS); TSA[tid] = rstd; TSB[tid] = -mean * rstd; }
        float lg[2], lb[2];
#pragma unroll
        for (int n = 0; n < 2; ++n) { lg[n] = lng[jx + 4 * n]; lb[n] = lnb[jx + 4 * n]; }
        EPI_BARRIER();
#pragma unroll
        for (int ai = 0; ai < 2; ++ai) {
            bf16x8 Xf[2][4];
#pragma unroll
            for (int n = 0; n < 2; ++n)
#pragma unroll
                for (int k = 0; k < 4; ++k) {
                    const LAS f32x4* ta = (const LAS f32x4*)(TSA + 128 * ai + 32 * k + 8 * fq);
                    const LAS f32x4* tb = (const LAS f32x4*)(TSB + 128 * ai + 32 * k + 8 * fq);
                    const f32x4 a0 = ta[0], a1 = ta[1], b0 = tb[0], b1 = tb[1];
                    const f32x2 lg2 = (f32x2){lg[n], lg[n]}, lb2 = (f32x2){lb[n], lb[n]};
                    u32x4 o;
#pragma unroll
                    for (int h = 0; h < 4; ++h) { const unsigned wd = raw[n][k][h];
                        const f32x2 f = (f32x2){__uint_as_float(wd << 16), __uint_as_float(wd & 0xffff0000u)};
                        const f32x2 aa = h == 0 ? (f32x2){a0[0], a0[1]} : h == 1 ? (f32x2){a0[2], a0[3]} : h == 2 ? (f32x2){a1[0], a1[1]} : (f32x2){a1[2], a1[3]};
                        const f32x2 bb = h == 0 ? (f32x2){b0[0], b0[1]} : h == 1 ? (f32x2){b0[2], b0[3]} : h == 2 ? (f32x2){b1[0], b1[1]} : (f32x2){b1[2], b1[3]};
                        const f32x2 v = (f * aa + bb) * lg2 + lb2;
                        o[h] = cvt_pk_bf16(v.x, v.y); }
                    Xf[n][k] = __builtin_bit_cast(bf16x8, o);
                }
            if (ai == 0) {
#pragma unroll
                for (int n = 0; n < 2; ++n)
#pragma unroll
                    for (int k = 0; k < 4; ++k) raw[n][k] = *(const u32x4*)(vbase + (size_t)2048 * 128 + n * 512 + 32 * k);
            }
#pragma unroll
            for (int m = 0; m < 4; ++m) {
                const int t = 64 * wr + 16 * m + fr;
                const bf16_t* wp = WS + ((size_t)grp * 128 + t) * 128 + 8 * fq;
                bf16x8 Yf[4];
#pragma unroll
                for (int k = 0; k < 4; ++k) Yf[k] = *(const bf16x8*)(wp + 32 * k);
                const float bst = bs[grp * 128 + t];
                f32x4 mx0 = (f32x4){0.f, 0.f, 0.f, 0.f}, mx1 = mx0;
#pragma unroll
                for (int k = 0; k < 4; ++k) { mx0 = __builtin_amdgcn_mfma_f32_16x16x32_bf16(Xf[0][k], Yf[k], mx0, 0, 0, 0); mx1 = __builtin_amdgcn_mfma_f32_16x16x32_bf16(Xf[1][k], Yf[k], mx1, 0, 0, 0); }
                const f32x4 y0 = silu4(acc[ai][1][m][0]) * (gelu4(acc[ai][0][m][0]) * (mx0 + bst));
                const f32x4 y1 = silu4(acc[ai][1][m][1]) * (gelu4(acc[ai][0][m][1]) * (mx1 + bst));
                u32x4 w; w.x = cvt_pk_bf16(y0[0], y0[1]); w.y = cvt_pk_bf16(y0[2], y0[3]); w.z = cvt_pk_bf16(y1[0], y1[1]); w.w = cvt_pk_bf16(y1[2], y1[3]);
                *(u32x4*)(Y + tiled_elem(256 * u.pm + 128 * ai + t, j0 + 32 * wc + 8 * fq, DE / 64)) = w;
            }
        }
    }
};

__device__ __forceinline__ f32x4 zero4() {
    f32x2 lo, hi;
    asm volatile("v_mov_b64 %0, 0" : "=v"(lo)); asm volatile("v_mov_b64 %0, 0" : "=v"(hi));
    return (f32x4){lo.x, lo.y, hi.x, hi.y};
}
template <class Epi>
__device__ __forceinline__ void gemm_phase(LAS unsigned char* lds, const GemmDesc g, const StaticOrder& S, const Epi& E) {
    const int tid = threadIdx.x, wid = __builtin_amdgcn_readfirstlane(tid >> 6), lane = tid & 63, wr = wid >> 2, wc = wid & 3, fr = lane & 15, fq = lane >> 4;
    const int K = g.K, nt = K / BK;
    unsigned voffA[2], voffB[2];
#pragma unroll
    for (int i = 0; i < 2; ++i) { int R, C; stage_rc(tid * 16 + i * 8192, R, C); voffA[i] = (unsigned)(tid * 16 + i * 8192); voffB[i] = Epi::boff(R, C, nt); }
    const size_t kstep = (size_t)16384;
    const size_t hstepA = g.hstepA, hstepB = g.hstepB;
    const unsigned ldsw = (unsigned)wid * 1024u;
    const int aoff = lds_byte(wr * 64 + fr, fq * 8), boff = lds_byte(wc * 32 + fr, fq * 8);
#define PG8_SA(b, h) (((b) * 2 + (h)) * HTB)
#define PG8_SB(b, h) ((4 + (b) * 2 + (h)) * HTB)
#define PG8_STAGE(bufoff, gbase, voff) do { _Pragma("unroll") for (int _i = 0; _i < 2; ++_i) \
        __builtin_amdgcn_global_load_lds((const unsigned*)((const char*)(gbase) + (voff)[_i]), (LAS unsigned*)(lds + (bufoff) + ldsw + _i * 8192), 16, 0, 0); } while (0)
#define PG8_LDA(dst, b, h) do { _Pragma("unroll") for (int m = 0; m < 4; ++m) _Pragma("unroll") for (int k = 0; k < 2; ++k) dst[m][k] = *(const LAS bf16x8*)(lds + PG8_SA(b, h) + aoff + m * 2048 + k * 1024); } while (0)
#define PG8_LDB(dst, b, h) do { _Pragma("unroll") for (int n = 0; n < 2; ++n) _Pragma("unroll") for (int k = 0; k < 2; ++k) dst[n][k] = *(const LAS bf16x8*)(lds + PG8_SB(b, h) + boff + n * 2048 + k * 1024); } while (0)
#define PG8_MMA(ai, bj, At, Bt) do { __builtin_amdgcn_s_setprio(1); _Pragma("unroll") for (int m = 0; m < 4; ++m) _Pragma("unroll") for (int n = 0; n < 2; ++n) _Pragma("unroll") for (int k = 0; k < 2; ++k) \
        acc[ai][bj][m][n] = __builtin_amdgcn_mfma_f32_16x16x32_bf16(Bt[n][k], At[m][k], acc[ai][bj][m][n], 0, 0, 0); __builtin_amdgcn_s_setprio(0); } while (0)
#define PG8_WAIT_V(n) asm volatile("s_waitcnt vmcnt(" #n ")" ::: "memory")
#define PG8_WAIT_L(n) asm volatile("s_waitcnt lgkmcnt(" #n ")" ::: "memory")
#define PG8_BAR __builtin_amdgcn_s_barrier()
#define PG8_SCHED __builtin_amdgcn_sched_barrier(0)
    Unit cur, nxt; int ui = 0;
    if (!S.next(0, cur)) return;
    f32x4 acc[2][2][4][2];
#pragma unroll
    for (int a = 0; a < 2; ++a)
#pragma unroll
        for (int b = 0; b < 2; ++b)
#pragma unroll
            for (int m = 0; m < 4; ++m)
#pragma unroll
                for (int n = 0; n < 2; ++n) acc[a][b][m][n] = zero4();
    bf16x8 At[4][2], B0[2][2], B1[2][2];
    const char* cA = (const char*)g.A + (size_t)cur.pm * g.tstepA; const char* cB = (const char*)g.Bt + (g.pnHalf ? (size_t)(cur.pn >> 1) * g.tstepB + (size_t)(cur.pn & 1) * 8192 : (size_t)cur.pn * g.tstepB);
    PG8_STAGE(PG8_SB(0, 0), cB, voffB); PG8_STAGE(PG8_SB(0, 1), cB + hstepB, voffB); PG8_STAGE(PG8_SA(0, 0), cA, voffA); PG8_STAGE(PG8_SA(0, 1), cA + hstepA, voffA);
    if (wr == 1) PG8_BAR;
    PG8_WAIT_V(2); PG8_BAR;
    PG8_STAGE(PG8_SB(1, 0), cB + kstep, voffB); PG8_STAGE(PG8_SA(1, 0), cA + kstep, voffA); PG8_STAGE(PG8_SB(1, 1), cB + hstepB + kstep, voffB);
    PG8_WAIT_V(6); PG8_BAR;
    for (;;) {
        const bool has_next = S.next(ui + 1, nxt);
        const char* nA = has_next ? (const char*)g.A + (size_t)nxt.pm * g.tstepA : cA; const char* nB = has_next ? (const char*)g.Bt + (g.pnHalf ? (size_t)(nxt.pn >> 1) * g.tstepB + (size_t)(nxt.pn & 1) * 8192 : (size_t)nxt.pn * g.tstepB) : cB;
        for (int t = 0; t < nt; t += 2) {
            const bool last = (t == nt - 2);
            const char* a1 = cA + (size_t)(t + 1) * kstep;
            const char* a2 = last ? nA : cA + (size_t)(t + 2) * kstep; const char* b2 = last ? nB : cB + (size_t)(t + 2) * kstep;
            const char* a3 = a2 + kstep; const char* b3 = b2 + kstep;
            PG8_LDB(B0, 0, 0); PG8_LDB(B1, 0, 1); PG8_SCHED; PG8_LDA(At, 0, 0); PG8_STAGE(PG8_SA(1, 1), a1 + hstepA, voffA);
            PG8_WAIT_V(8); PG8_WAIT_L(0); PG8_BAR; PG8_MMA(0, 0, At, B0); PG8_MMA(0, 1, At, B1); PG8_BAR; PG8_SCHED;
            PG8_LDA(At, 0, 1); PG8_STAGE(PG8_SB(0, 0), b2, voffB); PG8_STAGE(PG8_SB(0, 1), b2 + hstepB, voffB); PG8_STAGE(PG8_SA(0, 0), a2, voffA);
            PG8_WAIT_V(8); PG8_WAIT_L(0); PG8_BAR; PG8_MMA(1, 0, At, B0); PG8_MMA(1, 1, At, B1); PG8_BAR; PG8_SCHED;
            PG8_LDB(B0, 1, 0); PG8_LDB(B1, 1, 1); PG8_SCHED; PG8_LDA(At, 1, 0); PG8_STAGE(PG8_SA(0, 1), a2 + hstepA, voffA);
            PG8_WAIT_V(8); PG8_WAIT_L(0); PG8_BAR; PG8_MMA(0, 0, At, B0); PG8_MMA(0, 1, At, B1); PG8_BAR; PG8_SCHED;
            PG8_LDA(At, 1, 1); PG8_STAGE(PG8_SB(1, 0), b3, voffB); PG8_STAGE(PG8_SB(1, 1), b3 + hstepB, voffB); PG8_STAGE(PG8_SA(1, 0), a3, voffA);
            PG8_WAIT_V(8); PG8_WAIT_L(0); PG8_BAR; PG8_MMA(1, 0, At, B0); PG8_MMA(1, 1, At, B1); PG8_BAR; PG8_SCHED;
        }
        if (wr == 0) PG8_BAR;
        E(acc, cur, wr, wc, fr, fq, lds, tid);
        if (!has_next) break;
#pragma unroll
        for (int a = 0; a < 2; ++a)
#pragma unroll
            for (int b = 0; b < 2; ++b)
#pragma unroll
                for (int m = 0; m < 4; ++m)
#pragma unroll
                    for (int n = 0; n < 2; ++n) acc[a][b][m][n] = zero4();
        cur = nxt; cA = nA; cB = nB; ++ui;
        if (wr == 1) PG8_BAR;
    }
    PG8_WAIT_V(0);
    PG8_BAR;
#undef PG8_SA
#undef PG8_SB
#undef PG8_STAGE
#undef PG8_LDA
#undef PG8_LDB
#undef PG8_MMA
#undef PG8_WAIT_V
#undef PG8_WAIT_L
#undef PG8_BAR
#undef PG8_SCHED
}

__device__ __forceinline__ unsigned f2bf(float f) { unsigned u = __builtin_bit_cast(unsigned, f); return (u + 0x7fffu + ((u >> 16) & 1u)) >> 16; }
__device__ __forceinline__ unsigned pk2(float lo, float hi) { return f2bf(lo) | (f2bf(hi) << 16); }
__device__ __forceinline__ float wave_sum(float v) {
#pragma unroll
    for (int o = 1; o < 64; o <<= 1) v += __shfl_xor(v, o);
    return v;
}
__device__ __forceinline__ void p0_transpose_item(const float* W, int K, int N, bf16_t* WT, LAS float* scr, int item, int lane) {
    const int nblk = N / 32, kb = item / nblk, nb = item % nblk, k0 = 64 * kb, n0 = 32 * nb;
    float tv[32];
#pragma unroll
    for (int i = 0; i < 32; ++i) { const int kk = 2 * i + (lane >> 5); tv[i] = W[(size_t)(k0 + kk) * N + n0 + (lane & 31)]; }
#pragma unroll
    for (int i = 0; i < 32; ++i) { const int kk = 2 * i + (lane >> 5); scr[kk * 33 + (lane & 31)] = tv[i]; }
    asm volatile("s_waitcnt lgkmcnt(0)" ::: "memory");
    const int c = lane & 7;
#pragma unroll
    for (int jx = 0; jx < 4; ++jx) { const int n = (lane >> 3) + 8 * jx; const LAS float* s = scr + (8 * c) * 33 + n;
        u32x4 o; o.x = pk2(s[0 * 33], s[1 * 33]); o.y = pk2(s[2 * 33], s[3 * 33]); o.z = pk2(s[4 * 33], s[5 * 33]); o.w = pk2(s[6 * 33], s[7 * 33]);
        *(u32x4*)(WT + tiled_elem(n0 + n, k0 + 8 * c, K / 64)) = o; }
    asm volatile("s_waitcnt lgkmcnt(0)" ::: "memory");
}

#define XB_TMO      128
#define XB_XCNT(j)  (256  + 64 * (j))
#define XB_XSUB(j)  (1280 + 64 * (j))
#define XB_XGEN(j)  (2304 + 64 * (j))
#define XB_TOP      3328
#define XB_TOPGEN   3392
#define XB_SPIN_CAP (1u << 18)
__device__ __forceinline__ unsigned xb_ld(unsigned* p)              { return __hip_atomic_load(p, __ATOMIC_RELAXED, __HIP_MEMORY_SCOPE_AGENT); }
__device__ __forceinline__ unsigned xb_add(unsigned* p, unsigned v) { return __hip_atomic_fetch_add(p, v, __ATOMIC_RELAXED, __HIP_MEMORY_SCOPE_AGENT); }
__device__ __forceinline__ unsigned xb_xcc_id() { return (unsigned)__builtin_amdgcn_s_getreg((3 << 11) | 20) & 0xFu; }
#define XB_SPIN(cond, bar) do { unsigned _sp = 0; while (cond) { __builtin_amdgcn_s_sleep(1); \
    if ((++_sp & 255u) == 0u) { if (xb_ld(&(bar)[XB_TMO])) break; if (_sp > XB_SPIN_CAP) { atomicAdd(&(bar)[XB_TMO], 1u); break; } } } } while (0)
struct XcdBarrier { unsigned* bar; unsigned x; volatile LAS unsigned* st; };
__device__ __forceinline__ XcdBarrier xcd_barrier_post(unsigned* bar, volatile LAS unsigned* st) {
    XcdBarrier b; b.bar = bar; b.x = xb_xcc_id(); b.st = st;
    if (threadIdx.x == 0) (void)xb_add(&bar[XB_XCNT(b.x)], 1u);
    return b;
}
__device__ __forceinline__ void xcd_barrier_complete(unsigned* bar, unsigned x, unsigned& nloc, unsigned& nx) {
    const unsigned G = gridDim.x * gridDim.y * gridDim.z;
    unsigned sum, cnt, mine, sp = 0u;
    for (;;) {
        sum = 0u; cnt = 0u; mine = 0u;
#pragma unroll
        for (unsigned j = 0; j < 16; ++j) { const unsigned c = xb_ld(&bar[XB_XCNT(j)]); sum += c; cnt += (c > 0u) ? 1u : 0u; mine = (j == x) ? c : mine; }
        if (sum == G) break;
        __builtin_amdgcn_s_sleep(1);
        if ((++sp & 255u) == 0u) { if (xb_ld(&bar[XB_TMO])) break; if (sp > XB_SPIN_CAP) { atomicAdd(&bar[XB_TMO], 1u); break; } }
    }
    nloc = mine > 0u ? mine : 1u; nx = cnt > 0u ? cnt : 1u;
}
__device__ __forceinline__ void xcd_barrier(const XcdBarrier& b) {
    asm volatile("s_waitcnt vmcnt(0)" ::: "memory");
    __syncthreads();
    if (threadIdx.x == 0) {
        unsigned* bar = b.bar;
        __builtin_amdgcn_s_waitcnt(0);
        unsigned nloc = b.st[0], nx = b.st[1];
        if (nloc == 0u) { xcd_barrier_complete(bar, b.x, nloc, nx); b.st[0] = nloc; b.st[1] = nx; }
        const unsigned old = xb_add(&bar[XB_XSUB(b.x)], 1u);
        const unsigned gen = old / nloc;
        if (old + 1u == (gen + 1u) * nloc) {
            __builtin_amdgcn_fence(__ATOMIC_RELEASE, "agent");
            asm volatile("s_waitcnt vmcnt(0)" ::: "memory");
            const unsigned og = xb_add(&bar[XB_TOP], 1u);
            const unsigned tg = og / nx;
            if (og + 1u == (tg + 1u) * nx) xb_add(&bar[XB_TOPGEN], 1u);
            else XB_SPIN(xb_ld(&bar[XB_TOPGEN]) == tg, bar);
            __builtin_amdgcn_fence(__ATOMIC_ACQUIRE, "agent");
            xb_add(&bar[XB_XGEN(b.x)], 1u);
            asm volatile("s_waitcnt vmcnt(0)" ::: "memory");
        } else {
            XB_SPIN(xb_ld(&bar[XB_XGEN(b.x)]) == gen, bar);
            __builtin_amdgcn_fence(__ATOMIC_ACQUIRE, "agent");
            asm volatile("s_waitcnt vmcnt(0)" ::: "memory");
        }
    }
    __syncthreads();
}

struct Args { const float* in[16]; float* out; unsigned char* ws; int ph_lo, ph_hi; };

__device__ __forceinline__ void norm_rows_bf16(const float* X, bf16_t* H, const float* gam, const float* modl, int gw, int NGW, int lane) {
    for (int m0 = gw * 4; m0 < MT; m0 += NGW * 4) {
        const int b = m0 >> 13;
        f32x4 v[4][4]; float ss[4];
#pragma unroll
        for (int r = 0; r < 4; ++r) { const f32x4* xr = (const f32x4*)(X + (size_t)(m0 + r) * DM) + lane;
#pragma unroll
            for (int j = 0; j < 4; ++j) v[r][j] = xr[64 * j]; }
#pragma unroll
        for (int r = 0; r < 4; ++r) { float s = 0.f;
#pragma unroll
            for (int j = 0; j < 4; ++j) s += (v[r][j][0] * v[r][j][0] + v[r][j][1] * v[r][j][1]) + (v[r][j][2] * v[r][j][2] + v[r][j][3] * v[r][j][3]);
            ss[r] = 1.0f / sqrtf(wave_sum(s) * (1.0f / DM) + RMS_EPS); }
        const float* mb = modl + (size_t)b * 3072;
#pragma unroll
        for (int j = 0; j < 4; ++j) { const int col = 256 * j + 4 * lane;
            const f32x4 gg = *(const f32x4*)(gam + col), sh = *(const f32x4*)(mb + col), sc = *(const f32x4*)(mb + 1024 + col);
            const f32x4 mul = gg * (sc + 1.0f);
#pragma unroll
            for (int r = 0; r < 4; ++r) { const f32x4 o = v[r][j] * ss[r] * mul + sh;
                u32x2 w; w.x = pk2(o[0], o[1]); w.y = pk2(o[2], o[3]);
                *(u32x2*)(H + tiled_elem(m0 + r, col, DM / 64)) = w; } }
    }
}

__global__ void __launch_bounds__(512, 2) fwd_megakernel(Args args) {
    extern __shared__ __attribute__((aligned(16))) unsigned char lds_raw[];
    LAS unsigned char* lds = (LAS unsigned char*)lds_raw;
    cg::grid_group grid = cg::this_grid();
    const int tid = threadIdx.x, lane = tid & 63, wave = __builtin_amdgcn_readfirstlane(tid >> 6);
    const int G = gridDim.x, bx = blockIdx.x, gw = bx * 8 + wave, NGW = G * 8;
    unsigned char* ws = args.ws;
    const float* x = args.in[0]; const float* cvec = args.in[1]; const float* mod_w = args.in[2]; const float* mod_b = args.in[3]; const float* norm_g = args.in[4];
    const float* a_w_in = args.in[5]; const float* a_conv_w = args.in[6]; const float* a_conv_b = args.in[7]; const float* a_w_out = args.in[8];
    const float* b_w_in = args.in[9]; const float* b_ln_g = args.in[10]; const float* b_ln_b = args.in[11]; const float* b_w_s = args.in[12]; const float* b_b_s = args.in[13];
    const float* b_w_out = args.in[14]; const float* final_g = args.in[15];
    float* out = args.out;
    float* MOD = (float*)(ws + WS_MOD); f32x2* PART = (f32x2*)(ws + WS_PART);
    float* HG = (float*)(ws + WS_HG); float* GG = (float*)(ws + WS_GG); float* PC = (float*)(ws + WS_PC);
    bf16_t* WSb = (bf16_t*)(ws + WS_WS); bf16_t* W1t = (bf16_t*)(ws + WS_W1); bf16_t* W2t = (bf16_t*)(ws + WS_W2); bf16_t* W3t = (bf16_t*)(ws + WS_W3); bf16_t* W4t = (bf16_t*)(ws + WS_W4);
    bf16_t* H = (bf16_t*)(ws + WS_H); bf16_t* Y = (bf16_t*)(ws + WS_Y); bf16_t* VT = (bf16_t*)(ws + WS_VT);
    const int lo = args.ph_lo, hi = args.ph_hi;
    if (lo < 0) grid.sync();
#define IN(k) (lo <= (k) && (k) < hi)
#define SEAM(k) do { if (IN(k) && IN((k) + 1)) xcd_barrier(xbar); } while (0)
    volatile LAS unsigned* MISC = (volatile LAS unsigned*)(lds + EPI_OFF + 8192);
    if (tid < 2) MISC[tid] = 0u;
    __syncthreads();
    XcdBarrier xbar = xcd_barrier_post((unsigned*)(ws + WS_CTL) + 4096, MISC);

    if (IN(0)) {
        LAS float* sc = (LAS float*)lds;
        for (int it = bx; it < 384; it += G) {
            const int l = it / 192, r = it % 192, ks = r / 6, cgp = r % 6;
            __syncthreads();
            if (tid < 128) { const int b = tid >> 5, kk = tid & 31; const float cv = cvec[b * DM + ks * 32 + kk]; sc[tid] = cv / (1.0f + __expf(-cv)); }
            __syncthreads();
            const int n = cgp * 512 + tid;
            const float* w = mod_w + ((size_t)l * DM + ks * 32) * 3072 + n;
            float wv[32];
#pragma unroll
            for (int kk = 0; kk < 32; ++kk) wv[kk] = w[(size_t)kk * 3072];
            float a0 = 0.f, a1 = 0.f, a2 = 0.f, a3 = 0.f;
#pragma unroll
            for (int kk = 0; kk < 32; ++kk) { a0 += sc[kk] * wv[kk]; a1 += sc[32 + kk] * wv[kk]; a2 += sc[64 + kk] * wv[kk]; a3 += sc[96 + kk] * wv[kk]; }
            if (ks == 0) { const float bv = mod_b[l * 3072 + n]; a0 += bv; a1 += bv; a2 += bv; a3 += bv; }
            float* mp = MOD + (size_t)l * 4 * 3072 + n;
            atomicAdd(mp, a0); atomicAdd(mp + 3072, a1); atomicAdd(mp + 2 * 3072, a2); atomicAdd(mp + 3 * 3072, a3);
        }
        __syncthreads();
        LAS float* scr = (LAS float*)(lds + wave * 16384);
        constexpr int I1 = (DM / 64) * (4 * DE / 32), I2 = (DE / 64) * (DM / 32), I3 = (DM / 64) * (3 * DE / 32), I4 = I2;
        for (int it = gw; it < I1 + I2 + I3 + I4; it += NGW) {
            int r = it;
            if (r < I1) { p0_transpose_item(a_w_in, DM, 4 * DE, W1t, scr, r, lane); continue; } r -= I1;
            if (r < I2) { p0_transpose_item(a_w_out, DE, DM, W2t, scr, r, lane); continue; } r -= I2;
            if (r < I3) { p0_transpose_item(b_w_in, DM, 3 * DE, W3t, scr, r, lane); continue; } r -= I3;
            p0_transpose_item(b_w_out, DE, DM, W4t, scr, r, lane);
        }
        for (int i = bx * 512 + tid; i < 8 * 128 * 128; i += G * 512) { const int s = i & 127, t = (i >> 7) & 127; WSb[i] = (bf16_t)f2bf(s <= t ? b_w_s[i] : 0.0f); }
    }
    SEAM(0);
    if (IN(1)) norm_rows_bf16(x, H, norm_g, MOD, gw, NGW, lane);
    SEAM(1);
    if (IN(2)) {
        GemmDesc g{H, W1t, DM, (size_t)256 * DM * 2, (size_t)128 * DM * 2, (size_t)128 * DM * 2, (size_t)4096 * DM * 2, MT / 256, 32, 1};
        StaticOrder S; S.init(g.nM, g.nN, G, bx);
        EpiConv E{Y, a_conv_w, a_conv_b, HG, GG, PC};
        gemm_phase<EpiConv>(lds, g, S, E);
    }
    if (IN(2) && IN(4)) xcd_barrier(xbar);
    if (IN(4)) {
        GemmDesc g{Y, W2t, DE, (size_t)256 * DE * 2, (size_t)128 * DE * 2, (size_t)256 * DE * 2, (size_t)128 * DE * 2, MT / 256, 4, 0};
        StaticOrder S; S.init(g.nM, g.nN, G, bx);
        { Unit fu;
          for (int ui = 0; S.next(ui, fu); ++ui) {
            const int pm = fu.pm; if ((pm & 31) == 0) continue;
            for (int it = tid; it < 1024; it += 512) {
                const int i = it >> 9, j = (it & 511) * 4;
                const f32x4 g = *(const f32x4*)(GG + ((size_t)(pm * 2 + i)) * 2048 + j), pc = *(const f32x4*)(PC + ((size_t)(pm * 2 + i)) * 2048 + j);
                const f32x4 c15 = *(const f32x4*)(HG + ((size_t)((pm - 1) * 2 + 1)) * 2048 + j), c14 = *(const f32x4*)(HG + ((size_t)((pm - 1) * 2 + 0)) * 2048 + j);
                const f32x4 w0 = *(const f32x4*)(a_conv_w + j), w1 = *(const f32x4*)(a_conv_w + 2048 + j);
                const f32x4 add = (i == 0) ? (w1 * c15 + w0 * c14) : (w0 * c15);
                const f32x4 yv = g * (pc + add);
                u32x2 w; w.x = pk2(yv[0], yv[1]); w.y = pk2(yv[2], yv[3]);
                *(u32x2*)(Y + tiled_elem(pm * 256 + i, j, DE / 64)) = w;
            }
          }
          asm volatile("s_waitcnt vmcnt(0)" ::: "memory"); __syncthreads(); }
        EpiResNorm<0> E{x, out, H, MOD + 2048, norm_g + DM, MOD + 4 * 3072, (float*)(ws + WS_XS), (unsigned*)(ws + WS_CTL) + 8192, (bf16_t*)(ws + WS_X1)};
        gemm_phase<EpiResNorm<0>>(lds, g, S, E);
    }
    if (IN(4) && IN(6)) xcd_barrier(xbar);
    if (IN(6)) {
        GemmDesc g{W3t + (size_t)2048 * DM, H, DM, (size_t)256 * DM * 2, (size_t)128 * DM * 2, (size_t)256 * DM * 2, (size_t)128 * DM * 2, 8, MT / 256, 0};
        StaticOrder S; S.init(g.nM, g.nN, G, bx);
        EpiV E{VT, PART};
        gemm_phase<EpiV>(lds, g, S, E);
    }
    SEAM(6);
    if (IN(7)) {
        GemmDesc g{H, W3t, DM, (size_t)256 * DM * 2, (size_t)128 * DM * 2, (size_t)128 * DM * 2, (size_t)4096 * DM * 2, MT / 256, 16, 0};
        StaticOrder S; S.init(g.nM, g.nN, G, bx);
        EpiMix E{Y, VT, WSb, PART, b_ln_g, b_ln_b, b_b_s};
        gemm_phase<EpiMix>(lds, g, S, E);
    }
    SEAM(7);
    if (IN(8)) {
        GemmDesc g{Y, W4t, DE, (size_t)256 * DE * 2, (size_t)128 * DE * 2, (size_t)256 * DE * 2, (size_t)128 * DE * 2, MT / 256, 4, 0};
        StaticOrder S; S.init(g.nM, g.nN, G, bx);
        EpiResNorm<1> E{out, out, nullptr, MOD + 4 * 3072 + 2048, final_g, nullptr, (float*)(ws + WS_XS) + 128 * 4 * 256, (unsigned*)(ws + WS_CTL) + 8192 + 128 * 64, (bf16_t*)(ws + WS_X1)};
        gemm_phase<EpiResNorm<1>>(lds, g, S, E);
    }
#undef IN
#undef SEAM
}

#ifndef MK_MULTI
#define MK_MULTI 0
#endif
extern "C" void kernel_launch(void* const* d_in, const int* in_sizes, int n_in, void* d_out, int out_size, void* d_ws, size_t ws_size, hipStream_t stream) {
    static int grid = 0;
    if (grid == 0) {
        if (n_in != 16 || out_size != MT * DM || ws_size < WS_END) { fprintf(stderr, "kernel_launch: unexpected shapes (n_in %d out %d ws %zu)\n", n_in, out_size, ws_size); grid = -1; return; }
        int dev = 0, cus = 0, per_cu = 0;
        hipGetDevice(&dev); hipDeviceGetAttribute(&cus, hipDeviceAttributeMultiprocessorCount, dev);
        if (hipFuncSetAttribute((const void*)fwd_megakernel, hipFuncAttributeMaxDynamicSharedMemorySize, LDS_BYTES) != hipSuccess) { fprintf(stderr, "kernel_launch: hipFuncSetAttribute failed\n"); grid = -1; return; }
        if (hipOccupancyMaxActiveBlocksPerMultiprocessor(&per_cu, (const void*)fwd_megakernel, 512, LDS_BYTES) != hipSuccess || per_cu < 1) { fprintf(stderr, "kernel_launch: occupancy query says %d\n", per_cu); per_cu = 1; }
        (void)hipGetLastError();
        grid = cus * per_cu;
    }
    if (grid < 0) return;
    hipMemsetAsync((char*)d_ws + WS_CTL, 0, CTL_ZERO_BYTES, stream);
    Args a{};
    for (int i = 0; i < 16; ++i) a.in[i] = (const float*)d_in[i];
    a.out = (float*)d_out; a.ws = (unsigned char*)d_ws;
#if MK_MULTI
    for (int p = 0; p < 10; ++p) { a.ph_lo = p; a.ph_hi = p + 1; hipLaunchKernelGGL(fwd_megakernel, dim3(grid), dim3(512), LDS_BYTES, stream, a); }
#else
    a.ph_lo = 0; a.ph_hi = 10;
    void* kargs[] = {&a};
    hipError_t e = hipLaunchCooperativeKernel((const void*)fwd_megakernel, dim3(grid), dim3(512), kargs, LDS_BYTES, stream);
    if (e != hipSuccess) fprintf(stderr, "cooperative launch failed: %s (grid %d)\n", hipGetErrorString(e), grid);
#endif
}
```

```cpp
#include <hip/hip_runtime.h>
#include <hip/hip_cooperative_groups.h>
#include <cstdio>
#include <cstdint>
namespace cg = cooperative_groups;

#define LAS __attribute__((address_space(3)))
typedef unsigned short bf16_t;
typedef short bf16x8 __attribute__((ext_vector_type(8)));
typedef float f32x4 __attribute__((ext_vector_type(4)));
typedef float f32x2 __attribute__((ext_vector_type(2)));
typedef unsigned u32x4 __attribute__((ext_vector_type(4)));
typedef unsigned u32x2 __attribute__((ext_vector_type(2)));

constexpr int DM = 1024, NB = 4, SEQ = 8192, DE = 2048, MT = NB * SEQ;
constexpr float RMS_EPS = 1e-6f, LN_EPS = 1e-5f;
constexpr int YP = DE;

constexpr size_t MiB = 1u << 20;
constexpr size_t WS_CTL = 0, CTL_ZERO_BYTES = 256 * 1024;
constexpr size_t WS_MOD = 128 * 1024;
constexpr size_t WS_PART = 46 * MiB;
constexpr size_t WS_XS = 2 * MiB;
constexpr size_t WS_HG = 3 * MiB, WS_GG = 5 * MiB, WS_PC = 7 * MiB;
constexpr size_t WS_WS = 9 * MiB;
constexpr size_t WS_W1 = 10 * MiB;
constexpr size_t WS_W2 = 26 * MiB;
constexpr size_t WS_W3 = 30 * MiB;
constexpr size_t WS_W4 = 42 * MiB;
constexpr size_t WS_H = 48 * MiB;
constexpr size_t WS_Y = 112 * MiB;
constexpr size_t WS_VT = 248 * MiB;
constexpr size_t WS_X1 = 376 * MiB;
constexpr size_t WS_END = 440 * MiB;

constexpr int STAGE_BYTES = 131072, EPI_OFF = 131072, LDS_BYTES = 147456;

constexpr int BM = 256, BK = 64, HALF = 128, HTB = HALF * BK * 2, NXCD = 8, WGM = 8;
__host__ __device__ __forceinline__ int lds_byte(int r, int c) { const int st = (r >> 4) * 2 + (c >> 5), rr = r & 15, cc = c & 31, ob = rr * 64 + cc * 2; return st * 1024 + (ob ^ (((ob >> 9) & 1) << 5)); }
__host__ __device__ __forceinline__ void stage_rc(int b, int& R, int& C) { const int st = b / 1024, sb = b % 1024, swz = sb ^ (((sb >> 9) & 1) << 5); R = (st >> 1) * 16 + swz / 64; C = (st & 1) * 32 + (swz % 64) / 2; }
__host__ __device__ __forceinline__ int perm32(int rho) { const int n = rho >> 4, i = rho & 15; return 8 * (i >> 2) + 4 * n + (i & 3); }

__host__ __device__ __forceinline__ size_t tiled_elem(int row, int col, int nKt) { return (size_t)((row >> 7) * nKt + (col >> 6)) * 8192 + (size_t)(lds_byte(row & 127, col & 63) >> 1); }
struct Unit { int pm, pn; };
struct GemmDesc { const bf16_t* A; const bf16_t* Bt; int K; size_t tstepA, hstepA, tstepB, hstepB; int nM, nN; int pnHalf; };

struct StaticOrder {
    int nM, nN, nwg, G, c;
    __device__ void init(int nM_, int nN_, int G_, int c_) { nM = nM_; nN = nN_; nwg = nM * nN; G = G_; c = c_; }
    __device__ bool next(int i, Unit& u) const {
        const long L = (long)i * G + c; if (L >= nwg) return false;
        int wgid = (int)L; { const int q = nwg / NXCD, r = nwg % NXCD, xcd = wgid % NXCD, off = wgid / NXCD; wgid = (xcd < r ? xcd * (q + 1) : r * (q + 1) + (xcd - r) * q) + off; }
        const int nig = WGM * nN, gid = wgid / nig, fm = gid * WGM, gsz = (nM - fm) < WGM ? (nM - fm) : WGM;
        u.pm = fm + ((wgid % nig) % gsz); u.pn = (wgid % nig) / gsz; return true;
    }
};

__device__ __forceinline__ unsigned cvt_pk_bf16(float lo, float hi) { unsigned r; asm volatile("v_cvt_pk_bf16_f32 %0, %1, %2" : "=v"(r) : "v"(lo), "v"(hi)); return r; }
__device__ __forceinline__ f32x2 gelu_pk(f32x2 v) {
    const f32x2 av = __builtin_elementwise_abs(v), d = av * 0.2316418882f + 1.0f;
    f32x2 t; t.x = __builtin_amdgcn_rcpf(d.x); t.y = __builtin_amdgcn_rcpf(d.y);
    f32x2 q = t * 0.5307027145f + (-0.7265760135f); q = q * t + 0.7107068705f; q = q * t + (-0.142248368f); q = q * t + 0.127414796f; q = q * t;
    const f32x2 s = (v * v) * (-0.72134752044f);
    f32x2 e; e.x = __builtin_amdgcn_exp2f(s.x); e.y = __builtin_amdgcn_exp2f(s.y);
    const f32x2 c = 0.5f - q * e;
    return av * c + v * 0.5f;
}
__device__ __forceinline__ f32x4 gelu4(f32x4 v) { const f32x2 a = gelu_pk((f32x2){v[0], v[1]}), b = gelu_pk((f32x2){v[2], v[3]}); return (f32x4){a.x, a.y, b.x, b.y}; }
__device__ __forceinline__ float silu1(float z) { return z * __builtin_amdgcn_rcpf(1.0f + __builtin_amdgcn_exp2f(-1.4426950408889634f * z)); }
__device__ __forceinline__ f32x2 silu2(f32x2 z) {
    const f32x2 a = z * (-1.4426950408889634f);
    f32x2 e; e.x = __builtin_amdgcn_exp2f(a.x); e.y = __builtin_amdgcn_exp2f(a.y);
    const f32x2 d = e + 1.0f;
    f32x2 r; r.x = __builtin_amdgcn_rcpf(d.x); r.y = __builtin_amdgcn_rcpf(d.y);
    return z * r;
}
__device__ __forceinline__ f32x4 silu4(f32x4 z) { const f32x2 a = silu2((f32x2){z[0], z[1]}), b = silu2((f32x2){z[2], z[3]}); return (f32x4){a.x, a.y, b.x, b.y}; }
#define EPI_BARRIER() do { asm volatile("s_waitcnt lgkmcnt(0)" ::: "memory"); __builtin_amdgcn_s_barrier(); asm volatile("" ::: "memory"); } while (0)


struct EpiConv {
    static __host__ __device__ __forceinline__ unsigned boff(int R, int C, int nKt) { return (unsigned)(((R >> 4) & 1) * 16 * nKt) * 16384u + (unsigned)(R >> 5) * 2048u + (unsigned)lds_byte(R & 15, C); }
    bf16_t* Y; const float* cw; const float* cb; float* HG; float* GG; float* PC;
    __device__ __forceinline__ void operator()(f32x4 (&acc)[2][2][4][2], const Unit& u, int wr, int wc, int fr, int fq, LAS unsigned char* lds, int tid) const {
        LAS float* halo = (LAS float*)(lds + EPI_OFF);
        const int jl = 16 * wc + 4 * fq, j = 64 * u.pn + jl;
#pragma unroll
        for (int ai = 0; ai < 2; ++ai)
#pragma unroll
            for (int m = 0; m < 4; ++m) {
                const f32x4 Bg = acc[ai][0][m][0], Cg = acc[ai][0][m][1], Xi = acc[ai][1][m][0], Z = acc[ai][1][m][1];
                const f32x4 cx = Cg * Xi, g = silu4(Z) * Bg;
                acc[ai][0][m][1] = cx; acc[ai][1][m][1] = g;
                const int G = ai * 8 + wr * 4 + m;
                if (fr >= 14) {
                    *(LAS f32x4*)(halo + (G * 2 + (fr - 14)) * 64 + jl) = cx;
                    if (G == 15) *(f32x4*)(HG + ((size_t)(u.pm * 2 + (fr - 14))) * 2048 + j) = cx;
                }
            }
        EPI_BARRIER();
        const f32x4 w0 = *(const f32x4*)(cw + j), w1 = *(const f32x4*)(cw + 2048 + j), w2 = *(const f32x4*)(cw + 4096 + j), cbv = *(const f32x4*)(cb + j);
#pragma unroll
        for (int ai = 0; ai < 2; ++ai)
#pragma unroll
            for (int m = 0; m < 4; ++m) {
                const int G = ai * 8 + wr * 4 + m;
                const f32x4 cx = acc[ai][0][m][1], g = acc[ai][1][m][1];
                f32x4 h1 = (f32x4){0.f, 0.f, 0.f, 0.f}, hB = h1;
                if (G > 0) { h1 = *(const LAS f32x4*)(halo + ((G - 1) * 2 + 1) * 64 + jl); hB = *(const LAS f32x4*)(halo + ((G - 1) * 2 + (fr < 1 ? 0 : 1)) * 64 + jl); }
                f32x4 p1, p2;
#pragma unroll
                for (int e = 0; e < 4; ++e) { p1[e] = __shfl_up(cx[e], 1, 16); p2[e] = __shfl_up(cx[e], 2, 16); }
                if (fr < 1) p1 = h1;
                if (fr < 2) p2 = hB;
                const f32x4 pc = cbv + w2 * cx + w1 * p1 + w0 * p2, yv = g * pc;
                const size_t row = (size_t)u.pm * 256 + 16 * G + fr;
                u32x2 w; w.x = cvt_pk_bf16(yv[0], yv[1]); w.y = cvt_pk_bf16(yv[2], yv[3]);
                *(u32x2*)(Y + tiled_elem((int)row, j, DE / 64)) = w;
                if (G == 0 && fr < 2) { *(f32x4*)(GG + ((size_t)(u.pm * 2 + fr)) * 2048 + j) = g; *(f32x4*)(PC + ((size_t)(u.pm * 2 + fr)) * 2048 + j) = pc; }
            }
    }
};

struct EpiRes {
    static __host__ __device__ __forceinline__ unsigned boff(int R, int C, int nKt) { return (unsigned)lds_byte(R, C); }
    const float* xin; float* out; const float* gate;
    __device__ __forceinline__ void operator()(f32x4 (&acc)[2][2][4][2], const Unit& u, int wr, int wc, int fr, int fq, LAS unsigned char* lds, int tid) const {
        const int row0 = u.pm * BM + wr * 64 + fr, col0 = u.pn * BM + wc * 32 + 4 * fq;
        const float* gp = gate + (size_t)(u.pm >> 5) * 3072 + col0;
        f32x4 gv[2][2];
#pragma unroll
        for (int bj = 0; bj < 2; ++bj)
#pragma unroll
            for (int n = 0; n < 2; ++n) gv[bj][n] = *(const f32x4*)(gp + bj * HALF + n * 16);
#pragma unroll
        for (int ai = 0; ai < 2; ++ai)
#pragma unroll
            for (int m = 0; m < 4; ++m) { const size_t off = (size_t)(row0 + ai * HALF + m * 16) * DM + col0;
#pragma unroll
                for (int bj = 0; bj < 2; ++bj)
#pragma unroll
                    for (int n = 0; n < 2; ++n) { const f32x4 xv = *(const f32x4*)(xin + off + bj * HALF + n * 16); *(f32x4*)(out + off + bj * HALF + n * 16) = xv + gv[bj][n] * acc[ai][bj][m][n]; }
                if (m & 1) asm volatile("" ::: "memory"); }
    }
};

template <int MODE> struct EpiResNorm {
    static __host__ __device__ __forceinline__ unsigned boff(int R, int C, int nKt) { return (unsigned)lds_byte((R & ~31) + perm32(R & 31), C); }
    const float* xin; float* out; bf16_t* Hn; const float* gate; const float* gam; const float* modl; float* XS; unsigned* cnt; bf16_t* X1;
    __device__ __forceinline__ void operator()(f32x4 (&acc)[2][2][4][2], const Unit& u_, int wr_, int wc_, int fr_, int fq_, LAS unsigned char* lds, int tid_) const {
        Unit u; u.pm = u_.pm; u.pn = u_.pn; asm volatile("" : "+s"(u.pm), "+s"(u.pn));
        int tid = tid_; asm volatile("" : "+v"(tid));
        const int wid = __builtin_amdgcn_readfirstlane(tid >> 6), wr = wid >> 2, wc = wid & 3, fr = tid & 15, fq = (tid >> 4) & 3;
        LAS float* P = (LAS float*)(lds + EPI_OFF);
        LAS float* S = (LAS float*)(lds + EPI_OFF + 4096);
        const int b = u.pm >> 5;
        const int row0 = u.pm * BM + wr * 64 + fr, col0 = u.pn * BM + wc * 32 + 8 * fq;
        const unsigned x1base = (unsigned)(((u.pm * 4 + u.pn) * 8 + wid) * 16 * 512) + (unsigned)(tid & 63) * 8u;
        {
            f32x4 gv[2][2];
#pragma unroll
            for (int bj = 0; bj < 2; ++bj)
#pragma unroll
                for (int n = 0; n < 2; ++n) gv[bj][n] = *(const f32x4*)(gate + (size_t)b * 3072 + col0 + bj * HALF + 4 * n);
            if (MODE == 0) {
#pragma unroll
            for (int ai = 0; ai < 2; ++ai) {
                f32x4 xt[4][2][2];
#pragma unroll
                for (int m = 0; m < 4; ++m) { const unsigned off = (unsigned)(row0 + ai * HALF + m * 16) * DM + col0;
#pragma unroll
                    for (int bj = 0; bj < 2; ++bj)
#pragma unroll
                        for (int n = 0; n < 2; ++n) xt[m][bj][n] = *(const f32x4*)(xin + off + bj * HALF + 4 * n); }
#pragma unroll
                for (int m = 0; m < 4; ++m) {
#pragma unroll
                    for (int bj = 0; bj < 2; ++bj)
#pragma unroll
                        for (int n = 0; n < 2; ++n) acc[ai][bj][m][n] = xt[m][bj][n] + gv[bj][n] * acc[ai][bj][m][n];
                    asm volatile("" : "+v"(acc[ai][0][m][0]), "+v"(acc[ai][0][m][1]), "+v"(acc[ai][1][m][0]), "+v"(acc[ai][1][m][1]));
                }
                asm volatile("" ::: "memory"); __builtin_amdgcn_sched_barrier(0);
            }
            } else {
#pragma unroll
            for (int ai = 0; ai < 2; ++ai) {
                u32x4 xb[4][2];
#pragma unroll
                for (int m = 0; m < 4; ++m) {
#pragma unroll
                    for (int bj = 0; bj < 2; ++bj) xb[m][bj] = *(const u32x4*)(X1 + x1base + (unsigned)(((ai * 4 + m) * 2 + bj) * 512)); }
#pragma unroll
                for (int m = 0; m < 4; ++m) {
#pragma unroll
                    for (int bj = 0; bj < 2; ++bj) { const u32x4 w = xb[m][bj];
                        const f32x4 xa = (f32x4){__uint_as_float(w.x << 16), __uint_as_float(w.x & 0xffff0000u), __uint_as_float(w.y << 16), __uint_as_float(w.y & 0xffff0000u)};
                        const f32x4 xc = (f32x4){__uint_as_float(w.z << 16), __uint_as_float(w.z & 0xffff0000u), __uint_as_float(w.w << 16), __uint_as_float(w.w & 0xffff0000u)};
                        acc[ai][bj][m][0] = xa + gv[bj][0] * acc[ai][bj][m][0]; acc[ai][bj][m][1] = xc + gv[bj][1] * acc[ai][bj][m][1]; }
                    asm volatile("" : "+v"(acc[ai][0][m][0]), "+v"(acc[ai][0][m][1]), "+v"(acc[ai][1][m][0]), "+v"(acc[ai][1][m][1]));
                }
                asm volatile("" ::: "memory"); __builtin_amdgcn_sched_barrier(0);
            }
            }
        }
#pragma unroll
        for (int ai = 0; ai < 2; ++ai)
#pragma unroll
            for (int m = 0; m < 4; ++m) { float ss = 0.f;
#pragma unroll
                for (int bj = 0; bj < 2; ++bj)
#pragma unroll
                    for (int n = 0; n < 2; ++n) { const f32x4 v = acc[ai][bj][m][n]; ss += (v[0] * v[0] + v[1] * v[1]) + (v[2] * v[2] + v[3] * v[3]); }
                ss += __shfl_xor(ss, 16); ss += __shfl_xor(ss, 32);
                if (fq == 0) P[(ai * HALF + wr * 64 + m * 16 + fr) * 4 + wc] = ss; }
        EPI_BARRIER();
        if (wid < 4) {
            const f32x4 p = *(const LAS f32x4*)(P + tid * 4);
            __hip_atomic_store(XS + ((size_t)(u.pm * 4 + u.pn)) * 256 + tid, (p[0] + p[1]) + (p[2] + p[3]), __ATOMIC_RELAXED, __HIP_MEMORY_SCOPE_AGENT);
            asm volatile("s_waitcnt vmcnt(0)" ::: "memory");
            if ((tid & 63) == 0) __hip_atomic_fetch_add(cnt + 64 * u.pm, 1u, __ATOMIC_RELAXED, __HIP_MEMORY_SCOPE_AGENT);
        }
        if (MODE == 0) {
#pragma unroll
            for (int ai = 0; ai < 2; ++ai)
#pragma unroll
                for (int m = 0; m < 4; ++m) {
#pragma unroll
                    for (int bj = 0; bj < 2; ++bj) { const f32x4 a = acc[ai][bj][m][0], c = acc[ai][bj][m][1];
                        u32x4 w; w.x = cvt_pk_bf16(a[0], a[1]); w.y = cvt_pk_bf16(a[2], a[3]); w.z = cvt_pk_bf16(c[0], c[1]); w.w = cvt_pk_bf16(c[2], c[3]);
                        *(u32x4*)(X1 + x1base + (unsigned)(((ai * 4 + m) * 2 + bj) * 512)) = w; } }
        }
        if (wid == 0) {
            unsigned sp = 0;
            while ((unsigned)__builtin_amdgcn_readfirstlane(__hip_atomic_load(cnt + 64 * u.pm, __ATOMIC_RELAXED, __HIP_MEMORY_SCOPE_AGENT)) < 16u) { __builtin_amdgcn_s_sleep(1); if (++sp > (1u << 20)) break; }
            __builtin_amdgcn_fence(__ATOMIC_ACQUIRE, "agent");
            asm volatile("s_waitcnt vmcnt(0)" ::: "memory");
        }
        EPI_BARRIER();
        if (wid < 4) { float t = 0.f;
#pragma unroll
            for (int p = 0; p < 4; ++p) t += __hip_atomic_load(XS + ((size_t)(u.pm * 4 + p)) * 256 + tid, __ATOMIC_RELAXED, __HIP_MEMORY_SCOPE_AGENT);
            S[tid] = 1.0f / sqrtf(t * (1.0f / DM) + RMS_EPS); }
        EPI_BARRIER();
#pragma unroll
        for (int bj = 0; bj < 2; ++bj) {
            f32x4 mul[2], sh[2];
#pragma unroll
            for (int n = 0; n < 2; ++n) { const int c = col0 + bj * HALF + 4 * n; const f32x4 gg = *(const f32x4*)(gam + c);
                if (MODE == 0) { const f32x4 sc = *(const f32x4*)(modl + (size_t)b * 3072 + 1024 + c); mul[n] = gg * (sc + 1.0f); sh[n] = *(const f32x4*)(modl + (size_t)b * 3072 + c); }
                else { mul[n] = gg; sh[n] = (f32x4){0.f, 0.f, 0.f, 0.f}; } }
#pragma unroll
            for (int ai = 0; ai < 2; ++ai)
#pragma unroll
                for (int m = 0; m < 4; ++m) { const int r = ai * HALF + wr * 64 + m * 16 + fr; const float rs = S[r]; const unsigned off = (unsigned)(u.pm * BM + r) * DM + col0 + bj * HALF;
                    const f32x4 o0 = acc[ai][bj][m][0] * rs * mul[0] + sh[0], o1 = acc[ai][bj][m][1] * rs * mul[1] + sh[1];
                    if (MODE == 0) { u32x4 w; w.x = cvt_pk_bf16(o0[0], o0[1]); w.y = cvt_pk_bf16(o0[2], o0[3]); w.z = cvt_pk_bf16(o1[0], o1[1]); w.w = cvt_pk_bf16(o1[2], o1[3]); *(u32x4*)(Hn + tiled_elem(u.pm * BM + r, col0 + bj * HALF, DM / 64)) = w; }
                    else { *(f32x4*)(out + off) = o0; *(f32x4*)(out + off + 4) = o1; } }
            asm volatile("" ::: "memory");
        }
    }
};

__device__ __forceinline__ float row16_sum(float x) {
    x += __builtin_bit_cast(float, __builtin_amdgcn_update_dpp(0, __builtin_bit_cast(int, x), 0x128, 0xf, 0xf, true));
    x += __builtin_bit_cast(float, __builtin_amdgcn_update_dpp(0, __builtin_bit_cast(int, x), 0x124, 0xf, 0xf, true));
    x += __builtin_bit_cast(float, __builtin_amdgcn_update_dpp(0, __builtin_bit_cast(int, x), 0x122, 0xf, 0xf, true));
    x += __builtin_bit_cast(float, __builtin_amdgcn_update_dpp(0, __builtin_bit_cast(int, x), 0x121, 0xf, 0xf, true));
    return x;
}
struct EpiV {
    static __host__ __device__ __forceinline__ unsigned boff(int R, int C, int nKt) { return (unsigned)lds_byte((R & ~31) + perm32(R & 31), C); }
    bf16_t* VT; f32x2* PART;
    __device__ __forceinline__ void operator()(f32x4 (&acc)[2][2][4][2], const Unit& u, int wr, int wc, int fr, int fq, LAS unsigned char* lds, int tid) const {
        LAS float* red = (LAS float*)(lds + EPI_OFF);
#pragma unroll
        for (int bj = 0; bj < 2; ++bj) {
            const int chunk = 2 * u.pn + bj;
            f32x4 s0 = (f32x4){0.f, 0.f, 0.f, 0.f}, s1 = s0, q0 = s0, q1 = s0;
#pragma unroll
            for (int ai = 0; ai < 2; ++ai)
#pragma unroll
                for (int m = 0; m < 4; ++m) {
                    const int f = 256 * u.pm + 128 * ai + 64 * wr + 16 * m + fr;
                    const f32x4 v0 = gelu4(acc[ai][bj][m][0]), v1 = gelu4(acc[ai][bj][m][1]);
                    s0 += v0; s1 += v1; q0 += v0 * v0; q1 += v1 * v1;
                    u32x4 w; w.x = cvt_pk_bf16(v0[0], v0[1]); w.y = cvt_pk_bf16(v0[2], v0[3]); w.z = cvt_pk_bf16(v1[0], v1[1]); w.w = cvt_pk_bf16(v1[2], v1[3]);
                    *(u32x4*)(VT + ((((size_t)chunk * 128 + (f >> 4)) * 4 + wc) * 64 + fr * 4 + fq) * 8) = w;
                }
#pragma unroll
            for (int e = 0; e < 4; ++e) { s0[e] = row16_sum(s0[e]); s1[e] = row16_sum(s1[e]); q0[e] = row16_sum(q0[e]); q1[e] = row16_sum(q1[e]); }
            if (fr == 0) {
                LAS f32x4* rp = (LAS f32x4*)(red + ((size_t)((wr * 2 + bj) * 128) + 32 * wc + 8 * fq) * 2);
                rp[0] = (f32x4){s0[0], q0[0], s0[1], q0[1]}; rp[1] = (f32x4){s0[2], q0[2], s0[3], q0[3]};
                rp[2] = (f32x4){s1[0], q1[0], s1[1], q1[1]}; rp[3] = (f32x4){s1[2], q1[2], s1[3], q1[3]};
            }
        }
        EPI_BARRIER();
        if (tid < 256) { const LAS f32x2* r2 = (const LAS f32x2*)red; const int bj = tid >> 7, t = tid & 127;
            const f32x2 a = r2[(0 * 2 + bj) * 128 + t], b = r2[(1 * 2 + bj) * 128 + t];
            PART[(size_t)u.pm * MT + 256 * u.pn + tid] = a + b; }
    }
};

struct EpiMix {
    static __host__ __device__ __forceinline__ unsigned boff(int R, int C, int nKt) { return (unsigned)lds_byte((R & ~31) + perm32(R & 31), C); }
    bf16_t* Y; const bf16_t* VT; const bf16_t* WS; const f32x2* stats; const float* lng; const float* lnb; const float* bs;
    __device__ __forceinline__ void operator()(f32x4 (&acc)[2][2][4][2], const Unit& u_, int wr_, int wc_, int fr_, int fq_, LAS unsigned char* lds, int tid_) const {
        Unit u; u.pm = u_.pm; u.pn = u_.pn; asm volatile("" : "+s"(u.pm), "+s"(u.pn));
        int tid = tid_; asm volatile("" : "+v"(tid));
        const int wid = __builtin_amdgcn_readfirstlane(tid >> 6), wr = wid >> 2, wc = wid & 3, fr = tid & 15, fq = (tid >> 4) & 3;
        LAS float* TSA = (LAS float*)(lds + EPI_OFF);
        LAS float* TSB = (LAS float*)(lds + EPI_OFF + 1024);
        const int grp = u.pn >> 1, j0 = 128 * u.pn;
        const int jx = j0 + 32 * wc + 8 * (fr >> 2) + (fr & 3);
        const bf16_t* vbase = VT + ((((size_t)(2 * u.pm) * 128 + 8 * u.pn + 2 * wc + (fr >> 3)) * 4) * 64 + (8 * ((fr >> 2) & 1) + (fr & 3)) * 4 + fq) * 8;
        u32x4 raw[2][4];
#pragma unroll
        for (int n = 0; n < 2; ++n)
#pragma unroll
            for (int k = 0; k < 4; ++k) raw[n][k] = *(const u32x4*)(vbase + n * 128 + 512 * k);
        if (tid < 256) { const unsigned tok = 256u * u.pm + tid; f32x2 sq = stats[tok];
#pragma unroll
            for (int p = 1; p < 8; ++p) sq += stats[(size_t)p * MT + tok];
            const float mean = sq.x * (1.0f / 2048.0f); float var = sq.y * (1.0f / 2048.0f) - mean * mean; var = var < 0.f ? 0.f : var;
            const float rstd = 1.0f / sqrtf(var + LN_EPS); TSA[tid] = rstd; TSB[tid] = -mean * rstd; }
        float lg[2], lb[2];
#pragma unroll
        for (int n = 0; n < 2; ++n) { lg[n] = lng[jx + 4 * n]; lb[n] = lnb[jx + 4 * n]; }
        EPI_BARRIER();
#pragma unroll
        for (int ai = 0; ai < 2; ++ai) {
            bf16x8 Xf[2][4];
#pragma unroll
            for (int n = 0; n < 2; ++n)
#pragma unroll
                for (int k = 0; k < 4; ++k) {
                    const LAS f32x4* ta = (const LAS f32x4*)(TSA + 128 * ai + 32 * k + 8 * fq);
                    const LAS f32x4* tb = (const LAS f32x4*)(TSB + 128 * ai + 32 * k + 8 * fq);
                    const f32x4 a0 = ta[0], a1 = ta[1], b0 = tb[0], b1 = tb[1];
                    const f32x2 lg2 = (f32x2){lg[n], lg[n]}, lb2 = (f32x2){lb[n], lb[n]};
                    u32x4 o;
#pragma unroll
                    for (int h = 0; h < 4; ++h) { const unsigned wd = raw[n][k][h];
                        const f32x2 f = (f32x2){__uint_as_float(wd << 16), __uint_as_float(wd & 0xffff0000u)};
                        const f32x2 aa = h == 0 ? (f32x2){a0[0], a0[1]} : h == 1 ? (f32x2){a0[2], a0[3]} : h == 2 ? (f32x2){a1[0], a1[1]} : (f32x2){a1[2], a1[3]};
                        const f32x2 bb = h == 0 ? (f32x2){b0[0], b0[1]} : h == 1 ? (f32x2){b0[2], b0[3]} : h == 2 ? (f32x2){b1[0], b1[1]} : (f32x2){b1[2], b1[3]};
                        const f32x2 v = (f * aa + bb) * lg2 + lb2;
                        o[h] = cvt_pk_bf16(v.x, v.y); }
                    Xf[n][k] = __builtin_bit_cast(bf16x8, o);
                }
            if (ai == 0) {
#pragma unroll
                for (int n = 0; n < 2; ++n)
#pragma unroll
                    for (int k = 0; k < 4; ++k) raw[n][k] = *(const u32x4*)(vbase + (size_t)262144 + n * 128 + 512 * k);
            }
#pragma unroll
            for (int m = 0; m < 4; ++m) {
                const int t = 64 * wr + 16 * m + fr;
                const bf16_t* wp = WS + ((size_t)grp * 128 + t) * 128 + 8 * fq;
                bf16x8 Yf[4];
#pragma unroll
                for (int k = 0; k < 4; ++k) Yf[k] = *(const bf16x8*)(wp + 32 * k);
                const float bst = bs[grp * 128 + t];
                f32x4 mx0 = (f32x4){0.f, 0.f, 0.f, 0.f}, mx1 = mx0;
#pragma unroll
                for (int k = 0; k < 4; ++k) { mx0 = __builtin_amdgcn_mfma_f32_16x16x32_bf16(Xf[0][k], Yf[k], mx0, 0, 0, 0); mx1 = __builtin_amdgcn_mfma_f32_16x16x32_bf16(Xf[1][k], Yf[k], mx1, 0, 0, 0); }
                const f32x4 y0 = silu4(acc[ai][1][m][0]) * (gelu4(acc[ai][0][m][0]) * (mx0 + bst));
                const f32x4 y1 = silu4(acc[ai][1][m][1]) * (gelu4(acc[ai][0][m][1]) * (mx1 + bst));
                u32x4 w; w.x = cvt_pk_bf16(y0[0], y0[1]); w.y = cvt_pk_bf16(y0[2], y0[3]); w.z = cvt_pk_bf16(y1[0], y1[1]); w.w = cvt_pk_bf16(y1[2], y1[3]);
                *(u32x4*)(Y + tiled_elem(256 * u.pm + 128 * ai + t, j0 + 32 * wc + 8 * fq, DE / 64)) = w;
            }
        }
    }
};

__device__ __forceinline__ f32x4 zero4() {
    f32x2 lo, hi;
    asm volatile("v_mov_b64 %0, 0" : "=v"(lo)); asm volatile("v_mov_b64 %0, 0" : "=v"(hi));
    return (f32x4){lo.x, lo.y, hi.x, hi.y};
}
template <class Epi>
__device__ __forceinline__ void gemm_phase(LAS unsigned char* lds, const GemmDesc g, const StaticOrder& S, const Epi& E) {
    const int tid = threadIdx.x, wid = __builtin_amdgcn_readfirstlane(tid >> 6), lane = tid & 63, wr = wid >> 2, wc = wid & 3, fr = lane & 15, fq = lane >> 4;
    const int K = g.K, nt = K / BK;
    unsigned voffA[2], voffB[2];
#pragma unroll
    for (int i = 0; i < 2; ++i) { int R, C; stage_rc(tid * 16 + i * 8192, R, C); voffA[i] = (unsigned)(tid * 16 + i * 8192); voffB[i] = Epi::boff(R, C, nt); }
    const size_t kstep = (size_t)16384;
    const size_t hstepA = g.hstepA, hstepB = g.hstepB;
    const unsigned ldsw = (unsigned)wid * 1024u;
    const int aoff = lds_byte(wr * 64 + fr, fq * 8), boff = lds_byte(wc * 32 + fr, fq * 8);
#define PG8_SA(b, h) (((b) * 2 + (h)) * HTB)
#define PG8_SB(b, h) ((4 + (b) * 2 + (h)) * HTB)
#define PG8_STAGE(bufoff, gbase, voff) do { _Pragma("unroll") for (int _i = 0; _i < 2; ++_i) \
        __builtin_amdgcn_global_load_lds((const unsigned*)((const char*)(gbase) + (voff)[_i]), (LAS unsigned*)(lds + (bufoff) + ldsw + _i * 8192), 16, 0, 0); } while (0)
#define PG8_LDA(dst, b, h) do { _Pragma("unroll") for (int m = 0; m < 4; ++m) _Pragma("unroll") for (int k = 0; k < 2; ++k) dst[m][k] = *(const LAS bf16x8*)(lds + PG8_SA(b, h) + aoff + m * 2048 + k * 1024); } while (0)
#define PG8_LDB(dst, b, h) do { _Pragma("unroll") for (int n = 0; n < 2; ++n) _Pragma("unroll") for (int k = 0; k < 2; ++k) dst[n][k] = *(const LAS bf16x8*)(lds + PG8_SB(b, h) + boff + n * 2048 + k * 1024); } while (0)
#define PG8_MMA(ai, bj, At, Bt) do { __builtin_amdgcn_s_setprio(1); _Pragma("unroll") for (int m = 0; m < 4; ++m) _Pragma("unroll") for (int n = 0; n < 2; ++n) _Pragma("unroll") for (int k = 0; k < 2; ++k) \
        acc[ai][bj][m][n] = __builtin_amdgcn_mfma_f32_16x16x32_bf16(Bt[n][k], At[m][k], acc[ai][bj][m][n], 0, 0, 0); __builtin_amdgcn_s_setprio(0); } while (0)
#define PG8_WAIT_V(n) asm volatile("s_waitcnt vmcnt(" #n ")" ::: "memory")
#define PG8_WAIT_L(n) asm volatile("s_waitcnt lgkmcnt(" #n ")" ::: "memory")
#define PG8_BAR __builtin_amdgcn_s_barrier()
#define PG8_SCHED __builtin_amdgcn_sched_barrier(0)
    Unit cur, nxt; int ui = 0;
    if (!S.next(0, cur)) return;
    f32x4 acc[2][2][4][2];
#pragma unroll
    for (int a = 0; a < 2; ++a)
#pragma unroll
        for (int b = 0; b < 2; ++b)
#pragma unroll
            for (int m = 0; m < 4; ++m)
#pragma unroll
                for (int n = 0; n < 2; ++n) acc[a][b][m][n] = zero4();
    bf16x8 At[4][2], B0[2][2], B1[2][2];
    const char* cA = (const char*)g.A + (size_t)cur.pm * g.tstepA; const char* cB = (const char*)g.Bt + (g.pnHalf ? (size_t)(cur.pn >> 1) * g.tstepB + (size_t)(cur.pn & 1) * 8192 : (size_t)cur.pn * g.tstepB);
    PG8_STAGE(PG8_SB(0, 0), cB, voffB); PG8_STAGE(PG8_SB(0, 1), cB + hstepB, voffB); PG8_STAGE(PG8_SA(0, 0), cA, voffA); PG8_STAGE(PG8_SA(0, 1), cA + hstepA, voffA);
    if (wr == 1) PG8_BAR;
    PG8_WAIT_V(2); PG8_BAR;
    PG8_STAGE(PG8_SB(1, 0), cB + kstep, voffB); PG8_STAGE(PG8_SA(1, 0), cA + kstep, voffA); PG8_STAGE(PG8_SB(1, 1), cB + hstepB + kstep, voffB);
    PG8_WAIT_V(6); PG8_BAR;
    for (;;) {
        const bool has_next = S.next(ui + 1, nxt);
        const char* nA = has_next ? (const char*)g.A + (size_t)nxt.pm * g.tstepA : cA; const char* nB = has_next ? (const char*)g.Bt + (g.pnHalf ? (size_t)(nxt.pn >> 1) * g.tstepB + (size_t)(nxt.pn & 1) * 8192 : (size_t)nxt.pn * g.tstepB) : cB;
        for (int t = 0; t < nt; t += 2) {
            const bool last = (t == nt - 2);
            const char* a1 = cA + (size_t)(t + 1) * kstep;
            const char* a2 = last ? nA : cA + (size_t)(t + 2) * kstep; const char* b2 = last ? nB : cB + (size_t)(t + 2) * kstep;
            const char* a3 = a2 + kstep; const char* b3 = b2 + kstep;
            PG8_LDB(B0, 0, 0); PG8_LDB(B1, 0, 1); PG8_SCHED; PG8_LDA(At, 0, 0); PG8_STAGE(PG8_SA(1, 1), a1 + hstepA, voffA);
            PG8_WAIT_V(8); PG8_WAIT_L(0); PG8_BAR; PG8_MMA(0, 0, At, B0); PG8_MMA(0, 1, At, B1); PG8_BAR; PG8_SCHED;
            PG8_LDA(At, 0, 1); PG8_STAGE(PG8_SB(0, 0), b2, voffB); PG8_STAGE(PG8_SB(0, 1), b2 + hstepB, voffB); PG8_STAGE(PG8_SA(0, 0), a2, voffA);
            PG8_WAIT_V(8); PG8_WAIT_L(0); PG8_BAR; PG8_MMA(1, 0, At, B0); PG8_MMA(1, 1, At, B1); PG8_BAR; PG8_SCHED;
            PG8_LDB(B0, 1, 0); PG8_LDB(B1, 1, 1); PG8_SCHED; PG8_LDA(At, 1, 0); PG8_STAGE(PG8_SA(0, 1), a2 + hstepA, voffA);
            PG8_WAIT_V(8); PG8_WAIT_L(0); PG8_BAR; PG8_MMA(0, 0, At, B0); PG8_MMA(0, 1, At, B1); PG8_BAR; PG8_SCHED;
            PG8_LDA(At, 1, 1); PG8_STAGE(PG8_SB(1, 0), b3, voffB); PG8_STAGE(PG8_SB(1, 1), b3 + hstepB, voffB); PG8_STAGE(PG8_SA(1, 0), a3, voffA);
            PG8_WAIT_V(8); PG8_WAIT_L(0); PG8_BAR; PG8_MMA(1, 0, At, B0); PG8_MMA(1, 1, At, B1); PG8_BAR; PG8_SCHED;
        }
        if (wr == 0) PG8_BAR;
        E(acc, cur, wr, wc, fr, fq, lds, tid);
        if (!has_next) break;
#pragma unroll
        for (int a = 0; a < 2; ++a)
#pragma unroll
            for (int b = 0; b < 2; ++b)
#pragma unroll
                for (int m = 0; m < 4; ++m)
#pragma unroll
                    for (int n = 0; n < 2; ++n) acc[a][b][m][n] = zero4();
        cur = nxt; cA = nA; cB = nB; ++ui;
        if (wr == 1) PG8_BAR;
    }
    PG8_WAIT_V(0);
    PG8_BAR;
#undef PG8_SA
#undef PG8_SB
#undef PG8_STAGE
#undef PG8_LDA
#undef PG8_LDB
#undef PG8_MMA
#undef PG8_WAIT_V
#undef PG8_WAIT_L
#undef PG8_BAR
#undef PG8_SCHED
}

__device__ __forceinline__ unsigned f2bf(float f) { unsigned u = __builtin_bit_cast(unsigned, f); return (u + 0x7fffu + ((u >> 16) & 1u)) >> 16; }
__device__ __forceinline__ unsigned pk2(float lo, float hi) { return f2bf(lo) | (f2bf(hi) << 16); }
__device__ __forceinline__ float wave_sum(float v) {
#pragma unroll
    for (int o = 1; o < 64; o <<= 1) v += __shfl_xor(v, o);
    return v;
}
__device__ __forceinline__ void p0_transpose_item(const float* W, int K, int N, bf16_t* WT, LAS float* scr, int item, int lane) {
    const int nblk = N / 32, kb = item / nblk, nb = item % nblk, k0 = 64 * kb, n0 = 32 * nb;
    float tv[32];
#pragma unroll
    for (int i = 0; i < 32; ++i) { const int kk = 2 * i + (lane >> 5); tv[i] = W[(size_t)(k0 + kk) * N + n0 + (lane & 31)]; }
#pragma unroll
    for (int i = 0; i < 32; ++i) { const int kk = 2 * i + (lane >> 5); scr[kk * 33 + (lane & 31)] = tv[i]; }
    asm volatile("s_waitcnt lgkmcnt(0)" ::: "memory");
    const int c = lane & 7;
#pragma unroll
    for (int jx = 0; jx < 4; ++jx) { const int n = (lane >> 3) + 8 * jx; const LAS float* s = scr + (8 * c) * 33 + n;
        u32x4 o; o.x = pk2(s[0 * 33], s[1 * 33]); o.y = pk2(s[2 * 33], s[3 * 33]); o.z = pk2(s[4 * 33], s[5 * 33]); o.w = pk2(s[6 * 33], s[7 * 33]);
        *(u32x4*)(WT + tiled_elem(n0 + n, k0 + 8 * c, K / 64)) = o; }
    asm volatile("s_waitcnt lgkmcnt(0)" ::: "memory");
}

#define XB_TMO      128
#define XB_XCNT(j)  (256  + 64 * (j))
#define XB_XSUB(j)  (1280 + 64 * (j))
#define XB_XGEN(j)  (2304 + 64 * (j))
#define XB_TOP      3328
#define XB_TOPGEN   3392
#define XB_SPIN_CAP (1u << 18)
__device__ __forceinline__ unsigned xb_ld(unsigned* p)              { return __hip_atomic_load(p, __ATOMIC_RELAXED, __HIP_MEMORY_SCOPE_AGENT); }
__device__ __forceinline__ unsigned xb_add(unsigned* p, unsigned v) { return __hip_atomic_fetch_add(p, v, __ATOMIC_RELAXED, __HIP_MEMORY_SCOPE_AGENT); }
__device__ __forceinline__ unsigned xb_xcc_id() { return (unsigned)__builtin_amdgcn_s_getreg((3 << 11) | 20) & 0xFu; }
#define XB_SPIN(cond, bar) do { unsigned _sp = 0; while (cond) { __builtin_amdgcn_s_sleep(1); \
    if ((++_sp & 255u) == 0u) { if (xb_ld(&(bar)[XB_TMO])) break; if (_sp > XB_SPIN_CAP) { atomicAdd(&(bar)[XB_TMO], 1u); break; } } } } while (0)
struct XcdBarrier { unsigned* bar; unsigned x; volatile LAS unsigned* st; };
__device__ __forceinline__ XcdBarrier xcd_barrier_post(unsigned* bar, volatile LAS unsigned* st) {
    XcdBarrier b; b.bar = bar; b.x = xb_xcc_id(); b.st = st;
    if (threadIdx.x == 0) (void)xb_add(&bar[XB_XCNT(b.x)], 1u);
    return b;
}
__device__ __forceinline__ void xcd_barrier_complete(unsigned* bar, unsigned x, unsigned& nloc, unsigned& nx) {
    const unsigned G = gridDim.x * gridDim.y * gridDim.z;
    unsigned sum, cnt, mine, sp = 0u;
    for (;;) {
        sum = 0u; cnt = 0u; mine = 0u;
#pragma unroll
        for (unsigned j = 0; j < 16; ++j) { const unsigned c = xb_ld(&bar[XB_XCNT(j)]); sum += c; cnt += (c > 0u) ? 1u : 0u; mine = (j == x) ? c : mine; }
        if (sum == G) break;
        __builtin_amdgcn_s_sleep(1);
        if ((++sp & 255u) == 0u) { if (xb_ld(&bar[XB_TMO])) break; if (sp > XB_SPIN_CAP) { atomicAdd(&bar[XB_TMO], 1u); break; } }
    }
    nloc = mine > 0u ? mine : 1u; nx = cnt > 0u ? cnt : 1u;
}
__device__ __forceinline__ void xcd_barrier(const XcdBarrier& b) {
    asm volatile("s_waitcnt vmcnt(0)" ::: "memory");
    __syncthreads();
    if (threadIdx.x == 0) {
        unsigned* bar = b.bar;
        __builtin_amdgcn_s_waitcnt(0);
        unsigned nloc = b.st[0], nx = b.st[1];
        if (nloc == 0u) { xcd_barrier_complete(bar, b.x, nloc, nx); b.st[0] = nloc; b.st[1] = nx; }
        const unsigned old = xb_add(&bar[XB_XSUB(b.x)], 1u);
        const unsigned gen = old / nloc;
        if (old + 1u == (gen + 1u) * nloc) {
            __builtin_amdgcn_fence(__ATOMIC_RELEASE, "agent");
            asm volatile("s_waitcnt vmcnt(0)" ::: "memory");
            const unsigned og = xb_add(&bar[XB_TOP], 1u);
            const unsigned tg = og / nx;
            if (og + 1u == (tg + 1u) * nx) xb_add(&bar[XB_TOPGEN], 1u);
            else XB_SPIN(xb_ld(&bar[XB_TOPGEN]) == tg, bar);
            __builtin_amdgcn_fence(__ATOMIC_ACQUIRE, "agent");
            xb_add(&bar[XB_XGEN(b.x)], 1u);
            asm volatile("s_waitcnt vmcnt(0)" ::: "memory");
        } else {
            XB_SPIN(xb_ld(&bar[XB_XGEN(b.x)]) == gen, bar);
            __builtin_amdgcn_fence(__ATOMIC_ACQUIRE, "agent");
            asm volatile("s_waitcnt vmcnt(0)" ::: "memory");
        }
    }
    __syncthreads();
}

struct Args { const float* in[16]; float* out; unsigned char* ws; int ph_lo, ph_hi; };

__device__ __forceinline__ void norm_rows_bf16(const float* X, bf16_t* H, const float* gam, const float* modl, int gw, int NGW, int lane) {
    for (int m0 = gw * 4; m0 < MT; m0 += NGW * 4) {
        const int b = m0 >> 13;
        f32x4 v[4][4]; float ss[4];
#pragma unroll
        for (int r = 0; r < 4; ++r) { const f32x4* xr = (const f32x4*)(X + (size_t)(m0 + r) * DM) + lane;
#pragma unroll
            for (int j = 0; j < 4; ++j) v[r][j] = xr[64 * j]; }
#pragma unroll
        for (int r = 0; r < 4; ++r) { float s = 0.f;
#pragma unroll
            for (int j = 0; j < 4; ++j) s += (v[r][j][0] * v[r][j][0] + v[r][j][1] * v[r][j][1]) + (v[r][j][2] * v[r][j][2] + v[r][j][3] * v[r][j][3]);
            ss[r] = 1.0f / sqrtf(wave_sum(s) * (1.0f / DM) + RMS_EPS); }
        const float* mb = modl + (size_t)b * 3072;
#pragma unroll
        for (int j = 0; j < 4; ++j) { const int col = 256 * j + 4 * lane;
            const f32x4 gg = *(const f32x4*)(gam + col), sh = *(const f32x4*)(mb + col), sc = *(const f32x4*)(mb + 1024 + col);
            const f32x4 mul = gg * (sc + 1.0f);
#pragma unroll
            for (int r = 0; r < 4; ++r) { const f32x4 o = v[r][j] * ss[r] * mul + sh;
                u32x2 w; w.x = pk2(o[0], o[1]); w.y = pk2(o[2], o[3]);
                *(u32x2*)(H + tiled_elem(m0 + r, col, DM / 64)) = w; } }
    }
}

__global__ void __launch_bounds__(512, 2) fwd_megakernel(Args args) {
    extern __shared__ __attribute__((aligned(16))) unsigned char lds_raw[];
    LAS unsigned char* lds = (LAS unsigned char*)lds_raw;
    cg::grid_group grid = cg::this_grid();
    const int tid = threadIdx.x, lane = tid & 63, wave = __builtin_amdgcn_readfirstlane(tid >> 6);
    const int G = gridDim.x, bx = blockIdx.x, gw = bx * 8 + wave, NGW = G * 8;
    unsigned char* ws = args.ws;
    const float* x = args.in[0]; const float* cvec = args.in[1]; const float* mod_w = args.in[2]; const float* mod_b = args.in[3]; const float* norm_g = args.in[4];
    const float* a_w_in = args.in[5]; const float* a_conv_w = args.in[6]; const float* a_conv_b = args.in[7]; const float* a_w_out = args.in[8];
    const float* b_w_in = args.in[9]; const float* b_ln_g = args.in[10]; const float* b_ln_b = args.in[11]; const float* b_w_s = args.in[12]; const float* b_b_s = args.in[13];
    const float* b_w_out = args.in[14]; const float* final_g = args.in[15];
    float* out = args.out;
    float* MOD = (float*)(ws + WS_MOD); f32x2* PART = (f32x2*)(ws + WS_PART);
    float* HG = (float*)(ws + WS_HG); float* GG = (float*)(ws + WS_GG); float* PC = (float*)(ws + WS_PC);
    bf16_t* WSb = (bf16_t*)(ws + WS_WS); bf16_t* W1t = (bf16_t*)(ws + WS_W1); bf16_t* W2t = (bf16_t*)(ws + WS_W2); bf16_t* W3t = (bf16_t*)(ws + WS_W3); bf16_t* W4t = (bf16_t*)(ws + WS_W4);
    bf16_t* H = (bf16_t*)(ws + WS_H); bf16_t* Y = (bf16_t*)(ws + WS_Y); bf16_t* VT = (bf16_t*)(ws + WS_VT);
    const int lo = args.ph_lo, hi = args.ph_hi;
    if (lo < 0) grid.sync();
#define IN(k) (lo <= (k) && (k) < hi)
#define SEAM(k) do { if (IN(k) && IN((k) + 1)) xcd_barrier(xbar); } while (0)
    volatile LAS unsigned* MISC = (volatile LAS unsigned*)(lds + EPI_OFF + 8192);
    if (tid < 2) MISC[tid] = 0u;
    __syncthreads();
    XcdBarrier xbar = xcd_barrier_post((unsigned*)(ws + WS_CTL) + 4096, MISC);

    if (IN(0)) {
        LAS float* sc = (LAS float*)lds;
        for (int it = bx; it < 384; it += G) {
            const int l = it / 192, r = it % 192, ks = r / 6, cgp = r % 6;
            __syncthreads();
            if (tid < 128) { const int b = tid >> 5, kk = tid & 31; const float cv = cvec[b * DM + ks * 32 + kk]; sc[tid] = cv / (1.0f + __expf(-cv)); }
            __syncthreads();
            const int n = cgp * 512 + tid;
            const float* w = mod_w + ((size_t)l * DM + ks * 32) * 3072 + n;
            float wv[32];
#pragma unroll
            for (int kk = 0; kk < 32; ++kk) wv[kk] = w[(size_t)kk * 3072];
            float a0 = 0.f, a1 = 0.f, a2 = 0.f, a3 = 0.f;
#pragma unroll
            for (int kk = 0; kk < 32; ++kk) { a0 += sc[kk] * wv[kk]; a1 += sc[32 + kk] * wv[kk]; a2 += sc[64 + kk] * wv[kk]; a3 += sc[96 + kk] * wv[kk]; }
            if (ks == 0) { const float bv = mod_b[l * 3072 + n]; a0 += bv; a1 += bv; a2 += bv; a3 += bv; }
            float* mp = MOD + (size_t)l * 4 * 3072 + n;
            atomicAdd(mp, a0); atomicAdd(mp + 3072, a1); atomicAdd(mp + 2 * 3072, a2); atomicAdd(mp + 3 * 3072, a3);
        }
        __syncthreads();
        LAS float* scr = (LAS float*)(lds + wave * 16384);
        constexpr int I1 = (DM / 64) * (4 * DE / 32), I2 = (DE / 64) * (DM / 32), I3 = (DM / 64) * (3 * DE / 32), I4 = I2;
        for (int it = gw; it < I1 + I2 + I3 + I4; it += NGW) {
            int r = it;
            if (r < I1) { p0_transpose_item(a_w_in, DM, 4 * DE, W1t, scr, r, lane); continue; } r -= I1;
            if (r < I2) { p0_transpose_item(a_w_out, DE, DM, W2t, scr, r, lane); continue; } r -= I2;
            if (r < I3) { p0_transpose_item(b_w_in, DM, 3 * DE, W3t, scr, r, lane); continue; } r -= I3;
            p0_transpose_item(b_w_out, DE, DM, W4t, scr, r, lane);
        }
        for (int i = bx * 512 + tid; i < 8 * 128 * 128; i += G * 512) { const int s = i & 127, t = (i >> 7) & 127; WSb[i] = (bf16_t)f2bf(s <= t ? b_w_s[i] : 0.0f); }
    }
    SEAM(0);
    if (IN(1)) norm_rows_bf16(x, H, norm_g, MOD, gw, NGW, lane);
    SEAM(1);
    if (IN(2)) {
        GemmDesc g{H, W1t, DM, (size_t)256 * DM * 2, (size_t)128 * DM * 2, (size_t)128 * DM * 2, (size_t)4096 * DM * 2, MT / 256, 32, 1};
        StaticOrder S; S.init(g.nM, g.nN, G, bx);
        EpiConv E{Y, a_conv_w, a_conv_b, HG, GG, PC};
        gemm_phase<EpiConv>(lds, g, S, E);
    }
    if (IN(2) && IN(4)) xcd_barrier(xbar);
    if (IN(4)) {
        GemmDesc g{Y, W2t, DE, (size_t)256 * DE * 2, (size_t)128 * DE * 2, (size_t)256 * DE * 2, (size_t)128 * DE * 2, MT / 256, 4, 0};
        StaticOrder S; S.init(g.nM, g.nN, G, bx);
        { Unit fu;
          for (int ui = 0; S.next(ui, fu); ++ui) {
            const int pm = fu.pm; if ((pm & 31) == 0) continue;
            for (int it = tid; it < 1024; it += 512) {
                const int i = it >> 9, j = (it & 511) * 4;
                const f32x4 g = *(const f32x4*)(GG + ((size_t)(pm * 2 + i)) * 2048 + j), pc = *(const f32x4*)(PC + ((size_t)(pm * 2 + i)) * 2048 + j);
                const f32x4 c15 = *(const f32x4*)(HG + ((size_t)((pm - 1) * 2 + 1)) * 2048 + j), c14 = *(const f32x4*)(HG + ((size_t)((pm - 1) * 2 + 0)) * 2048 + j);
                const f32x4 w0 = *(const f32x4*)(a_conv_w + j), w1 = *(const f32x4*)(a_conv_w + 2048 + j);
                const f32x4 add = (i == 0) ? (w1 * c15 + w0 * c14) : (w0 * c15);
                const f32x4 yv = g * (pc + add);
                u32x2 w; w.x = pk2(yv[0], yv[1]); w.y = pk2(yv[2], yv[3]);
                *(u32x2*)(Y + tiled_elem(pm * 256 + i, j, DE / 64)) = w;
            }
          }
          asm volatile("s_waitcnt vmcnt(0)" ::: "memory"); __syncthreads(); }
        EpiResNorm<0> E{x, out, H, MOD + 2048, norm_g + DM, MOD + 4 * 3072, (float*)(ws + WS_XS), (unsigned*)(ws + WS_CTL) + 8192, (bf16_t*)(ws + WS_X1)};
        gemm_phase<EpiResNorm<0>>(lds, g, S, E);
    }
    if (IN(4) && IN(6)) xcd_barrier(xbar);
    if (IN(6)) {
        GemmDesc g{W3t + (size_t)2048 * DM, H, DM, (size_t)256 * DM * 2, (size_t)128 * DM * 2, (size_t)256 * DM * 2, (size_t)128 * DM * 2, 8, MT / 256, 0};
        StaticOrder S; S.init(g.nM, g.nN, G, bx);
        EpiV E{VT, PART};
        gemm_phase<EpiV>(lds, g, S, E);
    }
    SEAM(6);
    if (IN(7)) {
        GemmDesc g{H, W3t, DM, (size_t)256 * DM * 2, (size_t)128 * DM * 2, (size_t)128 * DM * 2, (size_t)4096 * DM * 2, MT / 256, 16, 0};
        StaticOrder S; S.init(g.nM, g.nN, G, bx);
        EpiMix E{Y, VT, WSb, PART, b_ln_g, b_ln_b, b_b_s};
        gemm_phase<EpiMix>(lds, g, S, E);
    }
    SEAM(7);
    if (IN(8)) {
        GemmDesc g{Y, W4t, DE, (size_t)256 * DE * 2, (size_t)128 * DE * 2, (size_t)256 * DE * 2, (size_t)128 * DE * 2, MT / 256, 4, 0};
        StaticOrder S; S.init(g.nM, g.nN, G, bx);
        EpiResNorm<1> E{out, out, nullptr, MOD + 4 * 3072 + 2048, final_g, nullptr, (float*)(ws + WS_XS) + 128 * 4 * 256, (unsigned*)(ws + WS_CTL) + 8192 + 128 * 64, (bf16_t*)(ws + WS_X1)};
        gemm_phase<EpiResNorm<1>>(lds, g, S, E);
    }
#undef IN
#undef SEAM
}

#ifndef MK_MULTI
#define MK_MULTI 0
#endif
extern "C" void kernel_launch(void* const* d_in, const int* in_sizes, int n_in, void* d_out, int out_size, void* d_ws, size_t ws_size, hipStream_t stream) {
    static int grid = 0;
    if (grid == 0) {
        if (n_in != 16 || out_size != MT * DM || ws_size < WS_END) { fprintf(stderr, "kernel_launch: unexpected shapes (n_in %d out %d ws %zu)\n", n_in, out_size, ws_size); grid = -1; return; }
        int dev = 0, cus = 0, per_cu = 0;
        hipGetDevice(&dev); hipDeviceGetAttribute(&cus, hipDeviceAttributeMultiprocessorCount, dev);
        if (hipFuncSetAttribute((const void*)fwd_megakernel, hipFuncAttributeMaxDynamicSharedMemorySize, LDS_BYTES) != hipSuccess) { fprintf(stderr, "kernel_launch: hipFuncSetAttribute failed\n"); grid = -1; return; }
        if (hipOccupancyMaxActiveBlocksPerMultiprocessor(&per_cu, (const void*)fwd_megakernel, 512, LDS_BYTES) != hipSuccess || per_cu < 1) { fprintf(stderr, "kernel_launch: occupancy query says %d\n", per_cu); per_cu = 1; }
        (void)hipGetLastError();
        grid = cus * per_cu;
    }
    if (grid < 0) return;
    hipMemsetAsync((char*)d_ws + WS_CTL, 0, CTL_ZERO_BYTES, stream);
    Args a{};
    for (int i = 0; i < 16; ++i) a.in[i] = (const float*)d_in[i];
    a.out = (float*)d_out; a.ws = (unsigned char*)d_ws;
#if MK_MULTI
    for (int p = 0; p < 10; ++p) { a.ph_lo = p; a.ph_hi = p + 1; hipLaunchKernelGGL(fwd_megakernel, dim3(grid), dim3(512), LDS_BYTES, stream, a); }
#else
    a.ph_lo = 0; a.ph_hi = 10;
    void* kargs[] = {&a};
    hipError_t e = hipLaunchCooperativeKernel((const void*)fwd_megakernel, dim3(grid), dim3(512), kargs, LDS_BYTES, stream);
    if (e != hipSuccess) fprintf(stderr, "cooperative launch failed: %s (grid %d)\n", hipGetErrorString(e), grid);
#endif
}
```

```cpp
#include <hip/hip_runtime.h>
#include <hip/hip_cooperative_groups.h>
#include <cstdio>
#include <cstdint>
namespace cg = cooperative_groups;

#define LAS __attribute__((address_space(3)))
typedef unsigned short bf16_t;
typedef short bf16x8 __attribute__((ext_vector_type(8)));
typedef float f32x4 __attribute__((ext_vector_type(4)));
typedef float f32x2 __attribute__((ext_vector_type(2)));
typedef unsigned u32x4 __attribute__((ext_vector_type(4)));
typedef unsigned u32x2 __attribute__((ext_vector_type(2)));

constexpr int DM = 1024, NB = 4, SEQ = 8192, DE = 2048, MT = NB * SEQ;
constexpr float RMS_EPS = 1e-6f, LN_EPS = 1e-5f;
constexpr int YP = DE;

constexpr size_t MiB = 1u << 20;
constexpr size_t WS_CTL = 0, CTL_ZERO_BYTES = 256 * 1024;
constexpr size_t WS_MOD = 128 * 1024;
constexpr size_t WS_PART = 46 * MiB;
constexpr size_t WS_XS = 2 * MiB;
constexpr size_t WS_HG = 3 * MiB, WS_GG = 5 * MiB, WS_PC = 7 * MiB;
constexpr size_t WS_WS = 9 * MiB;
constexpr size_t WS_W1 = 10 * MiB;
constexpr size_t WS_W2 = 26 * MiB;
constexpr size_t WS_W3 = 30 * MiB;
constexpr size_t WS_W4 = 42 * MiB;
constexpr size_t WS_H = 48 * MiB;
constexpr size_t WS_Y = 112 * MiB;
constexpr size_t WS_VT = 248 * MiB;
constexpr size_t WS_X1 = 376 * MiB;
constexpr size_t WS_END = 440 * MiB;

constexpr int STAGE_BYTES = 131072, EPI_OFF = 131072, LDS_BYTES = 147456;

constexpr int BM = 256, BK = 64, HALF = 128, HTB = HALF * BK * 2, NXCD = 8, WGM = 8;
__host__ __device__ __forceinline__ int lds_byte(int r, int c) { const int st = (r >> 4) * 2 + (c >> 5), rr = r & 15, cc = c & 31, ob = rr * 64 + cc * 2; return st * 1024 + (ob ^ (((ob >> 9) & 1) << 5)); }
__host__ __device__ __forceinline__ void stage_rc(int b, int& R, int& C) { const int st = b / 1024, sb = b % 1024, swz = sb ^ (((sb >> 9) & 1) << 5); R = (st >> 1) * 16 + swz / 64; C = (st & 1) * 32 + (swz % 64) / 2; }
__host__ __device__ __forceinline__ int perm32(int rho) { const int n = rho >> 4, i = rho & 15; return 8 * (i >> 2) + 4 * n + (i & 3); }

__host__ __device__ __forceinline__ size_t tiled_elem(int row, int col, int nKt) { return (size_t)((row >> 7) * nKt + (col >> 6)) * 8192 + (size_t)(lds_byte(row & 127, col & 63) >> 1); }
struct Unit { int pm, pn; };
struct GemmDesc { const bf16_t* A; const bf16_t* Bt; int K; size_t tstepA, hstepA, tstepB, hstepB; int nM, nN; int pnHalf; };

struct StaticOrder {
    int nM, nN, nwg, G, c;
    __device__ void init(int nM_, int nN_, int G_, int c_) { nM = nM_; nN = nN_; nwg = nM * nN; G = G_; c = c_; }
    __device__ bool next(int i, Unit& u) const {
        const long L = (long)i * G + c; if (L >= nwg) return false;
        int wgid = (int)L; { const int q = nwg / NXCD, r = nwg % NXCD, xcd = wgid % NXCD, off = wgid / NXCD; wgid = (xcd < r ? xcd * (q + 1) : r * (q + 1) + (xcd - r) * q) + off; }
        const int nig = WGM * nN, gid = wgid / nig, fm = gid * WGM, gsz = (nM - fm) < WGM ? (nM - fm) : WGM;
        u.pm = fm + ((wgid % nig) % gsz); u.pn = (wgid % nig) / gsz; return true;
    }
};

__device__ __forceinline__ unsigned cvt_pk_bf16(float lo, float hi) { unsigned r; asm volatile("v_cvt_pk_bf16_f32 %0, %1, %2" : "=v"(r) : "v"(lo), "v"(hi)); return r; }
__device__ __forceinline__ f32x2 gelu_pk(f32x2 v) {
    const f32x2 av = __builtin_elementwise_abs(v), d = av * 0.2316418882f + 1.0f;
    f32x2 t; t.x = __builtin_amdgcn_rcpf(d.x); t.y = __builtin_amdgcn_rcpf(d.y);
    f32x2 q = t * 0.5307027145f + (-0.7265760135f); q = q * t + 0.7107068705f; q = q * t + (-0.142248368f); q = q * t + 0.127414796f; q = q * t;
    const f32x2 s = (v * v) * (-0.72134752044f);
    f32x2 e; e.x = __builtin_amdgcn_exp2f(s.x); e.y = __builtin_amdgcn_exp2f(s.y);
    const f32x2 c = 0.5f - q * e;
    return av * c + v * 0.5f;
}
__device__ __forceinline__ f32x4 gelu4(f32x4 v) { const f32x2 a = gelu_pk((f32x2){v[0], v[1]}), b = gelu_pk((f32x2){v[2], v[3]}); return (f32x4){a.x, a.y, b.x, b.y}; }
__device__ __forceinline__ float silu1(float z) { return z * __builtin_amdgcn_rcpf(1.0f + __builtin_amdgcn_exp2f(-1.4426950408889634f * z)); }
__device__ __forceinline__ f32x2 silu2(f32x2 z) {
    const f32x2 a = z * (-1.4426950408889634f);
    f32x2 e; e.x = __builtin_amdgcn_exp2f(a.x); e.y = __builtin_amdgcn_exp2f(a.y);
    const f32x2 d = e + 1.0f;
    f32x2 r; r.x = __builtin_amdgcn_rcpf(d.x); r.y = __builtin_amdgcn_rcpf(d.y);
    return z * r;
}
__device__ __forceinline__ f32x4 silu4(f32x4 z) { const f32x2 a = silu2((f32x2){z[0], z[1]}), b = silu2((f32x2){z[2], z[3]}); return (f32x4){a.x, a.y, b.x, b.y}; }
#define EPI_BARRIER() do { asm volatile("s_waitcnt lgkmcnt(0)" ::: "memory"); __builtin_amdgcn_s_barrier(); asm volatile("" ::: "memory"); } while (0)


struct EpiConv {
    static __host__ __device__ __forceinline__ unsigned boff(int R, int C, int nKt) { return (unsigned)(((R >> 4) & 1) * 16 * nKt) * 16384u + (unsigned)(R >> 5) * 2048u + (unsigned)lds_byte(R & 15, C); }
    bf16_t* Y; const float* cw; const float* cb; float* HG; float* GG; float* PC;
    __device__ __forceinline__ void operator()(f32x4 (&acc)[2][2][4][2], const Unit& u, int wr, int wc, int fr, int fq, LAS unsigned char* lds, int tid) const {
        LAS float* halo = (LAS float*)(lds + EPI_OFF);
        const int jl = 16 * wc + 4 * fq, j = 64 * u.pn + jl;
#pragma unroll
        for (int ai = 0; ai < 2; ++ai)
#pragma unroll
            for (int m = 0; m < 4; ++m) {
                const f32x4 Bg = acc[ai][0][m][0], Cg = acc[ai][0][m][1], Xi = acc[ai][1][m][0], Z = acc[ai][1][m][1];
                const f32x4 cx = Cg * Xi, g = silu4(Z) * Bg;
                acc[ai][0][m][1] = cx; acc[ai][1][m][1] = g;
                const int G = ai * 8 + wr * 4 + m;
                if (fr >= 14) {
                    *(LAS f32x4*)(halo + (G * 2 + (fr - 14)) * 64 + jl) = cx;
                    if (G == 15) *(f32x4*)(HG + ((size_t)(u.pm * 2 + (fr - 14))) * 2048 + j) = cx;
                }
            }
        EPI_BARRIER();
        const f32x4 w0 = *(const f32x4*)(cw + j), w1 = *(const f32x4*)(cw + 2048 + j), w2 = *(const f32x4*)(cw + 4096 + j), cbv = *(const f32x4*)(cb + j);
#pragma unroll
        for (int ai = 0; ai < 2; ++ai)
#pragma unroll
            for (int m = 0; m < 4; ++m) {
                const int G = ai * 8 + wr * 4 + m;
                const f32x4 cx = acc[ai][0][m][1], g = acc[ai][1][m][1];
                f32x4 h1 = (f32x4){0.f, 0.f, 0.f, 0.f}, hB = h1;
                if (G > 0) { h1 = *(const LAS f32x4*)(halo + ((G - 1) * 2 + 1) * 64 + jl); hB = *(const LAS f32x4*)(halo + ((G - 1) * 2 + (fr < 1 ? 0 : 1)) * 64 + jl); }
                f32x4 p1, p2;
#pragma unroll
                for (int e = 0; e < 4; ++e) { p1[e] = __shfl_up(cx[e], 1, 16); p2[e] = __shfl_up(cx[e], 2, 16); }
                if (fr < 1) p1 = h1;
                if (fr < 2) p2 = hB;
                const f32x4 pc = cbv + w2 * cx + w1 * p1 + w0 * p2, yv = g * pc;
                const size_t row = (size_t)u.pm * 256 + 16 * G + fr;
                u32x2 w; w.x = cvt_pk_bf16(yv[0], yv[1]); w.y = cvt_pk_bf16(yv[2], yv[3]);
                *(u32x2*)(Y + tiled_elem((int)row, j, DE / 64)) = w;
                if (G == 0 && fr < 2) { *(f32x4*)(GG + ((size_t)(u.pm * 2 + fr)) * 2048 + j) = g; *(f32x4*)(PC + ((size_t)(u.pm * 2 + fr)) * 2048 + j) = pc; }
            }
    }
};

struct EpiRes {
    static __host__ __device__ __forceinline__ unsigned boff(int R, int C, int nKt) { return (unsigned)lds_byte(R, C); }
    const float* xin; float* out; const float* gate;
    __device__ __forceinline__ void operator()(f32x4 (&acc)[2][2][4][2], const Unit& u, int wr, int wc, int fr, int fq, LAS unsigned char* lds, int tid) const {
        const int row0 = u.pm * BM + wr * 64 + fr, col0 = u.pn * BM + wc * 32 + 4 * fq;
        const float* gp = gate + (size_t)(u.pm >> 5) * 3072 + col0;
        f32x4 gv[2][2];
#pragma unroll
        for (int bj = 0; bj < 2; ++bj)
#pragma unroll
            for (int n = 0; n < 2; ++n) gv[bj][n] = *(const f32x4*)(gp + bj * HALF + n * 16);
#pragma unroll
        for (int ai = 0; ai < 2; ++ai)
#pragma unroll
            for (int m = 0; m < 4; ++m) { const size_t off = (size_t)(row0 + ai * HALF + m * 16) * DM + col0;
#pragma unroll
                for (int bj = 0; bj < 2; ++bj)
#pragma unroll
                    for (int n = 0; n < 2; ++n) { const f32x4 xv = *(const f32x4*)(xin + off + bj * HALF + n * 16); *(f32x4*)(out + off + bj * HALF + n * 16) = xv + gv[bj][n] * acc[ai][bj][m][n]; }
                if (m & 1) asm volatile("" ::: "memory"); }
    }
};

template <int MODE> struct EpiResNorm {
    static __host__ __device__ __forceinline__ unsigned boff(int R, int C, int nKt) { return (unsigned)lds_byte((R & ~31) + perm32(R & 31), C); }
    const float* xin; float* out; bf16_t* Hn; const float* gate; const float* gam; const float* modl; float* XS; unsigned* cnt; bf16_t* X1;
    __device__ __forceinline__ void operator()(f32x4 (&acc)[2][2][4][2], const Unit& u_, int wr_, int wc_, int fr_, int fq_, LAS unsigned char* lds, int tid_) const {
        Unit u; u.pm = u_.pm; u.pn = u_.pn; asm volatile("" : "+s"(u.pm), "+s"(u.pn));
        int tid = tid_; asm volatile("" : "+v"(tid));
        const int wid = __builtin_amdgcn_readfirstlane(tid >> 6), wr = wid >> 2, wc = wid & 3, fr = tid & 15, fq = (tid >> 4) & 3;
        LAS float* P = (LAS float*)(lds + EPI_OFF);
        LAS float* S = (LAS float*)(lds + EPI_OFF + 4096);
        const int b = u.pm >> 5;
        const int row0 = u.pm * BM + wr * 64 + fr, col0 = u.pn * BM + wc * 32 + 8 * fq;
        const unsigned x1base = (unsigned)(((u.pm * 4 + u.pn) * 8 + wid) * 16 * 512) + (unsigned)(tid & 63) * 8u;
        {
            f32x4 gv[2][2];
#pragma unroll
            for (int bj = 0; bj < 2; ++bj)
#pragma unroll
                for (int n = 0; n < 2; ++n) gv[bj][n] = *(const f32x4*)(gate + (size_t)b * 3072 + col0 + bj * HALF + 4 * n);
            if (MODE == 0) {
#pragma unroll
            for (int ai = 0; ai < 2; ++ai) {
                f32x4 xt[4][2][2];
#pragma unroll
                for (int m = 0; m < 4; ++m) { const unsigned off = (unsigned)(row0 + ai * HALF + m * 16) * DM + col0;
#pragma unroll
                    for (int bj = 0; bj < 2; ++bj)
#pragma unroll
                        for (int n = 0; n < 2; ++n) xt[m][bj][n] = *(const f32x4*)(xin + off + bj * HALF + 4 * n); }
#pragma unroll
                for (int m = 0; m < 4; ++m) {
#pragma unroll
                    for (int bj = 0; bj < 2; ++bj)
#pragma unroll
                        for (int n = 0; n < 2; ++n) acc[ai][bj][m][n] = xt[m][bj][n] + gv[bj][n] * acc[ai][bj][m][n];
                    asm volatile("" : "+v"(acc[ai][0][m][0]), "+v"(acc[ai][0][m][1]), "+v"(acc[ai][1][m][0]), "+v"(acc[ai][1][m][1]));
                }
                asm volatile("" ::: "memory"); __builtin_amdgcn_sched_barrier(0);
            }
            } else {
#pragma unroll
            for (int ai = 0; ai < 2; ++ai) {
                u32x4 xb[4][2];
#pragma unroll
                for (int m = 0; m < 4; ++m) {
#pragma unroll
                    for (int bj = 0; bj < 2; ++bj) xb[m][bj] = *(const u32x4*)(X1 + x1base + (unsigned)(((ai * 4 + m) * 2 + bj) * 512)); }
#pragma unroll
                for (int m = 0; m < 4; ++m) {
#pragma unroll
                    for (int bj = 0; bj < 2; ++bj) { const u32x4 w = xb[m][bj];
                        const f32x4 xa = (f32x4){__uint_as_float(w.x << 16), __uint_as_float(w.x & 0xffff0000u), __uint_as_float(w.y << 16), __uint_as_float(w.y & 0xffff0000u)};
                        const f32x4 xc = (f32x4){__uint_as_float(w.z << 16), __uint_as_float(w.z & 0xffff0000u), __uint_as_float(w.w << 16), __uint_as_float(w.w & 0xffff0000u)};
                        acc[ai][bj][m][0] = xa + gv[bj][0] * acc[ai][bj][m][0]; acc[ai][bj][m][1] = xc + gv[bj][1] * acc[ai][bj][m][1]; }
                    asm volatile("" : "+v"(acc[ai][0][m][0]), "+v"(acc[ai][0][m][1]), "+v"(acc[ai][1][m][0]), "+v"(acc[ai][1][m][1]));
                }
                asm volatile("" ::: "memory"); __builtin_amdgcn_sched_barrier(0);
            }
            }
        }
#pragma unroll
        for (int ai = 0; ai < 2; ++ai)
#pragma unroll
            for (int m = 0; m < 4; ++m) { float ss = 0.f;
#pragma unroll
                for (int bj = 0; bj < 2; ++bj)
#pragma unroll
                    for (int n = 0; n < 2; ++n) { const f32x4 v = acc[ai][bj][m][n]; ss += (v[0] * v[0] + v[1] * v[1]) + (v[2] * v[2] + v[3] * v[3]); }
                ss += __shfl_xor(ss, 16); ss += __shfl_xor(ss, 32);
                if (fq == 0) P[(ai * HALF + wr * 64 + m * 16 + fr) * 4 + wc] = ss; }
        EPI_BARRIER();
        if (wid < 4) {
            const f32x4 p = *(const LAS f32x4*)(P + tid * 4);
            __hip_atomic_store(XS + ((size_t)(u.pm * 4 + u.pn)) * 256 + tid, (p[0] + p[1]) + (p[2] + p[3]), __ATOMIC_RELAXED, __HIP_MEMORY_SCOPE_AGENT);
            asm volatile("s_waitcnt vmcnt(0)" ::: "memory");
            if ((tid & 63) == 0) __hip_atomic_fetch_add(cnt + 64 * u.pm, 1u, __ATOMIC_RELAXED, __HIP_MEMORY_SCOPE_AGENT);
        }
        if (MODE == 0) {
#pragma unroll
            for (int ai = 0; ai < 2; ++ai)
#pragma unroll
                for (int m = 0; m < 4; ++m) {
#pragma unroll
                    for (int bj = 0; bj < 2; ++bj) { const f32x4 a = acc[ai][bj][m][0], c = acc[ai][bj][m][1];
                        u32x4 w; w.x = cvt_pk_bf16(a[0], a[1]); w.y = cvt_pk_bf16(a[2], a[3]); w.z = cvt_pk_bf16(c[0], c[1]); w.w = cvt_pk_bf16(c[2], c[3]);
                        *(u32x4*)(X1 + x1base + (unsigned)(((ai * 4 + m) * 2 + bj) * 512)) = w; } }
        }
        if (wid == 0) {
            unsigned sp = 0;
            while ((unsigned)__builtin_amdgcn_readfirstlane(__hip_atomic_load(cnt + 64 * u.pm, __ATOMIC_RELAXED, __HIP_MEMORY_SCOPE_AGENT)) < 16u) { __builtin_amdgcn_s_sleep(1); if (++sp > (1u << 20)) break; }
            __builtin_amdgcn_fence(__ATOMIC_ACQUIRE, "agent");
            asm volatile("s_waitcnt vmcnt(0)" ::: "memory");
        }
        EPI_BARRIER();
        if (wid < 4) { float t = 0.f;
#pragma unroll
            for (int p = 0; p < 4; ++p) t += __hip_atomic_load(XS + ((size_t)(u.pm * 4 + p)) * 256 + tid, __ATOMIC_RELAXED, __HIP_MEMORY_SCOPE_AGENT);
            S[tid] = 1.0f / sqrtf(t * (1.0f / DM) + RMS_EPS); }
        EPI_BARRIER();
#pragma unroll
        for (int bj = 0; bj < 2; ++bj) {
            f32x4 mul[2], sh[2];
#pragma unroll
            for (int n = 0; n < 2; ++n) { const int c = col0 + bj * HALF + 4 * n; const f32x4 gg = *(const f32x4*)(gam + c);
                if (MODE == 0) { const f32x4 sc = *(const f32x4*)(modl + (size_t)b * 3072 + 1024 + c); mul[n] = gg * (sc + 1.0f); sh[n] = *(const f32x4*)(modl + (size_t)b * 3072 + c); }
                else { mul[n] = gg; sh[n] = (f32x4){0.f, 0.f, 0.f, 0.f}; } }
#pragma unroll
            for (int ai = 0; ai < 2; ++ai)
#pragma unroll
                for (int m = 0; m < 4; ++m) { const int r = ai * HALF + wr * 64 + m * 16 + fr; const float rs = S[r]; const unsigned off = (unsigned)(u.pm * BM + r) * DM + col0 + bj * HALF;
                    const f32x4 o0 = acc[ai][bj][m][0] * rs * mul[0] + sh[0], o1 = acc[ai][bj][m][1] * rs * mul[1] + sh[1];
                    if (MODE == 0) { u32x4 w; w.x = cvt_pk_bf16(o0[0], o0[1]); w.y = cvt_pk_bf16(o0[2], o0[3]); w.z = cvt_pk_bf16(o1[0], o1[1]); w.w = cvt_pk_bf16(o1[2], o1[3]); *(u32x4*)(Hn + tiled_elem(u.pm * BM + r, col0 + bj * HALF, DM / 64)) = w; }
                    else { *(f32x4*)(out + off) = o0; *(f32x4*)(out + off + 4) = o1; } }
            asm volatile("" ::: "memory");
        }
    }
};

__device__ __forceinline__ float row16_sum(float x) {
    x += __builtin_bit_cast(float, __builtin_amdgcn_update_dpp(0, __builtin_bit_cast(int, x), 0x128, 0xf, 0xf, true));
    x += __builtin_bit_cast(float, __builtin_amdgcn_update_dpp(0, __builtin_bit_cast(int, x), 0x124, 0xf, 0xf, true));
    x += __builtin_bit_cast(float, __builtin_amdgcn_update_dpp(0, __builtin_bit_cast(int, x), 0x122, 0xf, 0xf, true));
    x += __builtin_bit_cast(float, __builtin_amdgcn_update_dpp(0, __builtin_bit_cast(int, x), 0x121, 0xf, 0xf, true));
    return x;
}
struct EpiV {
    static __host__ __device__ __forceinline__ unsigned boff(int R, int C, int nKt) { return (unsigned)lds_byte((R & ~31) + perm32(R & 31), C); }
    bf16_t* VT; f32x2* PART;
    __device__ __forceinline__ void operator()(f32x4 (&acc)[2][2][4][2], const Unit& u, int wr, int wc, int fr, int fq, LAS unsigned char* lds, int tid) const {
        LAS float* red = (LAS float*)(lds + EPI_OFF);
#pragma unroll
        for (int bj = 0; bj < 2; ++bj) {
            const int chunk = 2 * u.pn + bj;
            f32x4 s0 = (f32x4){0.f, 0.f, 0.f, 0.f}, s1 = s0, q0 = s0, q1 = s0;
#pragma unroll
            for (int ai = 0; ai < 2; ++ai)
#pragma unroll
                for (int m = 0; m < 4; ++m) {
                    const int f = 256 * u.pm + 128 * ai + 64 * wr + 16 * m + fr;
                    const f32x4 v0 = gelu4(acc[ai][bj][m][0]), v1 = gelu4(acc[ai][bj][m][1]);
                    s0 += v0; s1 += v1; q0 += v0 * v0; q1 += v1 * v1;
                    u32x4 w; w.x = cvt_pk_bf16(v0[0], v0[1]); w.y = cvt_pk_bf16(v0[2], v0[3]); w.z = cvt_pk_bf16(v1[0], v1[1]); w.w = cvt_pk_bf16(v1[2], v1[3]);
                    *(u32x4*)(VT + ((((size_t)chunk * 128 + (f >> 4)) * 4 + wc) * 64 + fr * 4 + fq) * 8) = w;
                }
#pragma unroll
            for (int e = 0; e < 4; ++e) { s0[e] = row16_sum(s0[e]); s1[e] = row16_sum(s1[e]); q0[e] = row16_sum(q0[e]); q1[e] = row16_sum(q1[e]); }
            if (fr == 0) {
                LAS f32x4* rp = (LAS f32x4*)(red + ((size_t)((wr * 2 + bj) * 128) + 32 * wc + 8 * fq) * 2);
                rp[0] = (f32x4){s0[0], q0[0], s0[1], q0[1]}; rp[1] = (f32x4){s0[2], q0[2], s0[3], q0[3]};
                rp[2] = (f32x4){s1[0], q1[0], s1[1], q1[1]}; rp[3] = (f32x4){s1[2], q1[2], s1[3], q1[3]};
            }
        }
        EPI_BARRIER();
        if (tid < 256) { const LAS f32x2* r2 = (const LAS f32x2*)red; const int bj = tid >> 7, t = tid & 127;
            const f32x2 a = r2[(0 * 2 + bj) * 128 + t], b = r2[(1 * 2 + bj) * 128 + t];
            PART[(size_t)u.pm * MT + 256 * u.pn + tid] = a + b; }
    }
};

struct EpiMix {
    static __host__ __device__ __forceinline__ unsigned boff(int R, int C, int nKt) { return (unsigned)lds_byte((R & ~31) + perm32(R & 31), C); }
    bf16_t* Y; const bf16_t* VT; const bf16_t* WS; const f32x2* stats; const float* lng; const float* lnb; const float* bs;
    __device__ __forceinline__ void operator()(f32x4 (&acc)[2][2][4][2], const Unit& u_, int wr_, int wc_, int fr_, int fq_, LAS unsigned char* lds, int tid_) const {
        Unit u; u.pm = u_.pm; u.pn = u_.pn; asm volatile("" : "+s"(u.pm), "+s"(u.pn));
        int tid = tid_; asm volatile("" : "+v"(tid));
        const int wid = __builtin_amdgcn_readfirstlane(tid >> 6), wr = wid >> 2, wc = wid & 3, fr = tid & 15, fq = (tid >> 4) & 3;
        LAS float* TSA = (LAS float*)(lds + EPI_OFF);
        LAS float* TSB = (LAS float*)(lds + EPI_OFF + 1024);
        const int grp = u.pn >> 1, j0 = 128 * u.pn;
        const int jx = j0 + 32 * wc + 8 * (fr >> 2) + (fr & 3);
        const bf16_t* vbase = VT + ((((size_t)(2 * u.pm) * 128 + 8 * u.pn + 2 * wc + (fr >> 3)) * 4) * 64 + (8 * ((fr >> 2) & 1) + (fr & 3)) * 4 + fq) * 8;
        u32x4 raw[2][4];
#pragma unroll
        for (int n = 0; n < 2; ++n)
#pragma unroll
            for (int k = 0; k < 4; ++k) raw[n][k] = *(const u32x4*)(vbase + n * 128 + 512 * k);
        if (tid < 256) { const unsigned tok = 256u * u.pm + tid; f32x2 sq = stats[tok];
#pragma unroll
            for (int p = 1; p < 8; ++p) sq += stats[(size_t)p * MT + tok];
            const float mean = sq.x * (1.0f / 2048.0f); float var = sq.y * (1.0f / 2048.0f) - mean * mean; var = var < 0.f ? 0.f : var;
            const float rstd = 1.0f / sqrtf(var + LN_EPS); TSA[tid] = rstd; TSB[tid] = -mean * rstd; }
        float lg[2], lb[2];
#pragma unroll
        for (int n = 0; n < 2; ++n) { lg[n] = lng[jx + 4 * n]; lb[n] = lnb[jx + 4 * n]; }
        EPI_BARRIER();
#pragma unroll
        for (int ai = 0; ai < 2; ++ai) {
            bf16x8 Xf[2][4];
#pragma unroll
            for (int n = 0; n < 2; ++n)
#pragma unroll
                for (int k = 0; k < 4; ++k) {
                    const LAS f32x4* ta = (const LAS f32x4*)(TSA + 128 * ai + 32 * k + 8 * fq);
                    const LAS f32x4* tb = (const LAS f32x4*)(TSB + 128 * ai + 32 * k + 8 * fq);
                    const f32x4 a0 = ta[0], a1 = ta[1], b0 = tb[0], b1 = tb[1];
                    const f32x2 lg2 = (f32x2){lg[n], lg[n]}, lb2 = (f32x2){lb[n], lb[n]};
                    u32x4 o;
#pragma unroll
                    for (int h = 0; h < 4; ++h) { const unsigned wd = raw[n][k][h];
                        const f32x2 f = (f32x2){__uint_as_float(wd << 16), __uint_as_float(wd & 0xffff0000u)};
                        const f32x2 aa = h == 0 ? (f32x2){a0[0], a0[1]} : h == 1 ? (f32x2){a0[2], a0[3]} : h == 2 ? (f32x2){a1[0], a1[1]} : (f32x2){a1[2], a1[3]};
                        const f32x2 bb = h == 0 ? (f32x2){b0[0], b0[1]} : h == 1 ? (f32x2){b0[2], b0[3]} : h == 2 ? (f32x2){b1[0], b1[1]} : (f32x2){b1[2], b1[3]};
                        const f32x2 v = (f * aa + bb) * lg2 + lb2;
                        o[h] = cvt_pk_bf16(v.x, v.y); }
                    Xf[n][k] = __builtin_bit_cast(bf16x8, o);
                }
            if (ai == 0) {
#pragma unroll
                for (int n = 0; n < 2; ++n)
#pragma unroll
                    for (int k = 0; k < 4; ++k) raw[n][k] = *(const u32x4*)(vbase + (size_t)262144 + n * 128 + 512 * k);
            }
#pragma unroll
            for (int m = 0; m < 4; ++m) {
                const int t = 64 * wr + 16 * m + fr;
                const bf16_t* wp = WS + ((((size_t)grp * 8 + 4 * wr + m) * 4) * 64 + fr * 4 + fq) * 8;
                bf16x8 Yf[4];
#pragma unroll
                for (int k = 0; k < 4; ++k) Yf[k] = *(const bf16x8*)(wp + 512 * k);
                const float bst = bs[grp * 128 + t];
                f32x4 mx0 = (f32x4){0.f, 0.f, 0.f, 0.f}, mx1 = mx0;
#pragma unroll
                for (int k = 0; k < 4; ++k) { mx0 = __builtin_amdgcn_mfma_f32_16x16x32_bf16(Xf[0][k], Yf[k], mx0, 0, 0, 0); mx1 = __builtin_amdgcn_mfma_f32_16x16x32_bf16(Xf[1][k], Yf[k], mx1, 0, 0, 0); }
                const f32x4 y0 = silu4(acc[ai][1][m][0]) * (gelu4(acc[ai][0][m][0]) * (mx0 + bst));
                const f32x4 y1 = silu4(acc[ai][1][m][1]) * (gelu4(acc[ai][0][m][1]) * (mx1 + bst));
                u32x4 w; w.x = cvt_pk_bf16(y0[0], y0[1]); w.y = cvt_pk_bf16(y0[2], y0[3]); w.z = cvt_pk_bf16(y1[0], y1[1]); w.w = cvt_pk_bf16(y1[2], y1[3]);
                *(u32x4*)(Y + tiled_elem(256 * u.pm + 128 * ai + t, j0 + 32 * wc + 8 * fq, DE / 64)) = w;
            }
        }
    }
};

__device__ __forceinline__ f32x4 zero4() {
    f32x2 lo, hi;
    asm volatile("v_mov_b64 %0, 0" : "=v"(lo)); asm volatile("v_mov_b64 %0, 0" : "=v"(hi));
    return (f32x4){lo.x, lo.y, hi.x, hi.y};
}
template <class Epi>
__device__ __forceinline__ void gemm_phase(LAS unsigned char* lds, const GemmDesc g, const StaticOrder& S, const Epi& E) {
    const int tid = threadIdx.x, wid = __builtin_amdgcn_readfirstlane(tid >> 6), lane = tid & 63, wr = wid >> 2, wc = wid & 3, fr = lane & 15, fq = lane >> 4;
    const int K = g.K, nt = K / BK;
    unsigned voffA[2], voffB[2];
#pragma unroll
    for (int i = 0; i < 2; ++i) { int R, C; stage_rc(tid * 16 + i * 8192, R, C); voffA[i] = (unsigned)(tid * 16 + i * 8192); voffB[i] = Epi::boff(R, C, nt); }
    const size_t kstep = (size_t)16384;
    const size_t hstepA = g.hstepA, hstepB = g.hstepB;
    const unsigned ldsw = (unsigned)wid * 1024u;
    const int aoff = lds_byte(wr * 64 + fr, fq * 8), boff = lds_byte(wc * 32 + fr, fq * 8);
#define PG8_SA(b, h) (((b) * 2 + (h)) * HTB)
#define PG8_SB(b, h) ((4 + (b) * 2 + (h)) * HTB)
#define PG8_STAGE(bufoff, gbase, voff) do { _Pragma("unroll") for (int _i = 0; _i < 2; ++_i) \
        __builtin_amdgcn_global_load_lds((const unsigned*)((const char*)(gbase) + (voff)[_i]), (LAS unsigned*)(lds + (bufoff) + ldsw + _i * 8192), 16, 0, 0); } while (0)
#define PG8_LDA(dst, b, h) do { _Pragma("unroll") for (int m = 0; m < 4; ++m) _Pragma("unroll") for (int k = 0; k < 2; ++k) dst[m][k] = *(const LAS bf16x8*)(lds + PG8_SA(b, h) + aoff + m * 2048 + k * 1024); } while (0)
#define PG8_LDB(dst, b, h) do { _Pragma("unroll") for (int n = 0; n < 2; ++n) _Pragma("unroll") for (int k = 0; k < 2; ++k) dst[n][k] = *(const LAS bf16x8*)(lds + PG8_SB(b, h) + boff + n * 2048 + k * 1024); } while (0)
#define PG8_MMA(ai, bj, At, Bt) do { __builtin_amdgcn_s_setprio(1); _Pragma("unroll") for (int m = 0; m < 4; ++m) _Pragma("unroll") for (int n = 0; n < 2; ++n) _Pragma("unroll") for (int k = 0; k < 2; ++k) \
        acc[ai][bj][m][n] = __builtin_amdgcn_mfma_f32_16x16x32_bf16(Bt[n][k], At[m][k], acc[ai][bj][m][n], 0, 0, 0); __builtin_amdgcn_s_setprio(0); } while (0)
#define PG8_WAIT_V(n) asm volatile("s_waitcnt vmcnt(" #n ")" ::: "memory")
#define PG8_WAIT_L(n) asm volatile("s_waitcnt lgkmcnt(" #n ")" ::: "memory")
#define PG8_BAR __builtin_amdgcn_s_barrier()
#define PG8_SCHED __builtin_amdgcn_sched_barrier(0)
    Unit cur, nxt; int ui = 0;
    if (!S.next(0, cur)) return;
    f32x4 acc[2][2][4][2];
#pragma unroll
    for (int a = 0; a < 2; ++a)
#pragma unroll
        for (int b = 0; b < 2; ++b)
#pragma unroll
            for (int m = 0; m < 4; ++m)
#pragma unroll
                for (int n = 0; n < 2; ++n) acc[a][b][m][n] = zero4();
    bf16x8 At[4][2], B0[2][2], B1[2][2];
    const char* cA = (const char*)g.A + (size_t)cur.pm * g.tstepA; const char* cB = (const char*)g.Bt + (g.pnHalf ? (size_t)(cur.pn >> 1) * g.tstepB + (size_t)(cur.pn & 1) * 8192 : (size_t)cur.pn * g.tstepB);
    PG8_STAGE(PG8_SB(0, 0), cB, voffB); PG8_STAGE(PG8_SB(0, 1), cB + hstepB, voffB); PG8_STAGE(PG8_SA(0, 0), cA, voffA); PG8_STAGE(PG8_SA(0, 1), cA + hstepA, voffA);
    if (wr == 1) PG8_BAR;
    PG8_WAIT_V(2); PG8_BAR;
    PG8_STAGE(PG8_SB(1, 0), cB + kstep, voffB); PG8_STAGE(PG8_SA(1, 0), cA + kstep, voffA); PG8_STAGE(PG8_SB(1, 1), cB + hstepB + kstep, voffB);
    PG8_WAIT_V(6); PG8_BAR;
    for (;;) {
        const bool has_next = S.next(ui + 1, nxt);
        const char* nA = has_next ? (const char*)g.A + (size_t)nxt.pm * g.tstepA : cA; const char* nB = has_next ? (const char*)g.Bt + (g.pnHalf ? (size_t)(nxt.pn >> 1) * g.tstepB + (size_t)(nxt.pn & 1) * 8192 : (size_t)nxt.pn * g.tstepB) : cB;
        for (int t = 0; t < nt; t += 2) {
            const bool last = (t == nt - 2);
            const char* a1 = cA + (size_t)(t + 1) * kstep;
            const char* a2 = last ? nA : cA + (size_t)(t + 2) * kstep; const char* b2 = last ? nB : cB + (size_t)(t + 2) * kstep;
            const char* a3 = a2 + kstep; const char* b3 = b2 + kstep;
            PG8_LDB(B0, 0, 0); PG8_LDB(B1, 0, 1); PG8_SCHED; PG8_LDA(At, 0, 0); PG8_STAGE(PG8_SA(1, 1), a1 + hstepA, voffA);
            PG8_WAIT_V(8); PG8_WAIT_L(0); PG8_BAR; PG8_MMA(0, 0, At, B0); PG8_MMA(0, 1, At, B1); PG8_BAR; PG8_SCHED;
            PG8_LDA(At, 0, 1); PG8_STAGE(PG8_SB(0, 0), b2, voffB); PG8_STAGE(PG8_SB(0, 1), b2 + hstepB, voffB); PG8_STAGE(PG8_SA(0, 0), a2, voffA);
            PG8_WAIT_V(8); PG8_WAIT_L(0); PG8_BAR; PG8_MMA(1, 0, At, B0); PG8_MMA(1, 1, At, B1); PG8_BAR; PG8_SCHED;
            PG8_LDB(B0, 1, 0); PG8_LDB(B1, 1, 1); PG8_SCHED; PG8_LDA(At, 1, 0); PG8_STAGE(PG8_SA(0, 1), a2 + hstepA, voffA);
            PG8_WAIT_V(8); PG8_WAIT_L(0); PG8_BAR; PG8_MMA(0, 0, At, B0); PG8_MMA(0, 1, At, B1); PG8_BAR; PG8_SCHED;
            PG8_LDA(At, 1, 1); PG8_STAGE(PG8_SB(1, 0), b3, voffB); PG8_STAGE(PG8_SB(1, 1), b3 + hstepB, voffB); PG8_STAGE(PG8_SA(1, 0), a3, voffA);
            PG8_WAIT_V(8); PG8_WAIT_L(0); PG8_BAR; PG8_MMA(1, 0, At, B0); PG8_MMA(1, 1, At, B1); PG8_BAR; PG8_SCHED;
        }
        if (wr == 0) PG8_BAR;
        E(acc, cur, wr, wc, fr, fq, lds, tid);
        if (!has_next) break;
#pragma unroll
        for (int a = 0; a < 2; ++a)
#pragma unroll
            for (int b = 0; b < 2; ++b)
#pragma unroll
                for (int m = 0; m < 4; ++m)
#pragma unroll
                    for (int n = 0; n < 2; ++n) acc[a][b][m][n] = zero4();
        cur = nxt; cA = nA; cB = nB; ++ui;
        if (wr == 1) PG8_BAR;
    }
    PG8_WAIT_V(0);
    PG8_BAR;
#undef PG8_SA
#undef PG8_SB
#undef PG8_STAGE
#undef PG8_LDA
#undef PG8_LDB
#undef PG8_MMA
#undef PG8_WAIT_V
#undef PG8_WAIT_L
#undef PG8_BAR
#undef PG8_SCHED
}

__device__ __forceinline__ unsigned f2bf(float f) { unsigned u = __builtin_bit_cast(unsigned, f); return (u + 0x7fffu + ((u >> 16) & 1u)) >> 16; }
__device__ __forceinline__ unsigned pk2(float lo, float hi) { return f2bf(lo) | (f2bf(hi) << 16); }
__device__ __forceinline__ float wave_sum(float v) {
#pragma unroll
    for (int o = 1; o < 64; o <<= 1) v += __shfl_xor(v, o);
    return v;
}
__device__ __forceinline__ void p0_transpose_item(const float* W, int K, int N, bf16_t* WT, LAS float* scr, int item, int lane) {
    const int nblk = N / 32, kb = item / nblk, nb = item % nblk, k0 = 64 * kb, n0 = 32 * nb;
    float tv[32];
#pragma unroll
    for (int i = 0; i < 32; ++i) { const int kk = 2 * i + (lane >> 5); tv[i] = W[(size_t)(k0 + kk) * N + n0 + (lane & 31)]; }
#pragma unroll
    for (int i = 0; i < 32; ++i) { const int kk = 2 * i + (lane >> 5); scr[kk * 33 + (lane & 31)] = tv[i]; }
    asm volatile("s_waitcnt lgkmcnt(0)" ::: "memory");
    const int c = lane & 7;
#pragma unroll
    for (int jx = 0; jx < 4; ++jx) { const int n = (lane >> 3) + 8 * jx; const LAS float* s = scr + (8 * c) * 33 + n;
        u32x4 o; o.x = pk2(s[0 * 33], s[1 * 33]); o.y = pk2(s[2 * 33], s[3 * 33]); o.z = pk2(s[4 * 33], s[5 * 33]); o.w = pk2(s[6 * 33], s[7 * 33]);
        *(u32x4*)(WT + tiled_elem(n0 + n, k0 + 8 * c, K / 64)) = o; }
    asm volatile("s_waitcnt lgkmcnt(0)" ::: "memory");
}

#define XB_TMO      128
#define XB_XCNT(j)  (256  + 64 * (j))
#define XB_XSUB(j)  (1280 + 64 * (j))
#define XB_XGEN(j)  (2304 + 64 * (j))
#define XB_TOP      3328
#define XB_TOPGEN   3392
#define XB_SPIN_CAP (1u << 18)
__device__ __forceinline__ unsigned xb_ld(unsigned* p)              { return __hip_atomic_load(p, __ATOMIC_RELAXED, __HIP_MEMORY_SCOPE_AGENT); }
__device__ __forceinline__ unsigned xb_add(unsigned* p, unsigned v) { return __hip_atomic_fetch_add(p, v, __ATOMIC_RELAXED, __HIP_MEMORY_SCOPE_AGENT); }
__device__ __forceinline__ unsigned xb_xcc_id() { return (unsigned)__builtin_amdgcn_s_getreg((3 << 11) | 20) & 0xFu; }
#define XB_SPIN(cond, bar) do { unsigned _sp = 0; while (cond) { __builtin_amdgcn_s_sleep(1); \
    if ((++_sp & 255u) == 0u) { if (xb_ld(&(bar)[XB_TMO])) break; if (_sp > XB_SPIN_CAP) { atomicAdd(&(bar)[XB_TMO], 1u); break; } } } } while (0)
struct XcdBarrier { unsigned* bar; unsigned x; volatile LAS unsigned* st; };
__device__ __forceinline__ XcdBarrier xcd_barrier_post(unsigned* bar, volatile LAS unsigned* st) {
    XcdBarrier b; b.bar = bar; b.x = xb_xcc_id(); b.st = st;
    if (threadIdx.x == 0) (void)xb_add(&bar[XB_XCNT(b.x)], 1u);
    return b;
}
__device__ __forceinline__ void xcd_barrier_complete(unsigned* bar, unsigned x, unsigned& nloc, unsigned& nx) {
    const unsigned G = gridDim.x * gridDim.y * gridDim.z;
    unsigned sum, cnt, mine, sp = 0u;
    for (;;) {
        sum = 0u; cnt = 0u; mine = 0u;
#pragma unroll
        for (unsigned j = 0; j < 16; ++j) { const unsigned c = xb_ld(&bar[XB_XCNT(j)]); sum += c; cnt += (c > 0u) ? 1u : 0u; mine = (j == x) ? c : mine; }
        if (sum == G) break;
        __builtin_amdgcn_s_sleep(1);
        if ((++sp & 255u) == 0u) { if (xb_ld(&bar[XB_TMO])) break; if (sp > XB_SPIN_CAP) { atomicAdd(&bar[XB_TMO], 1u); break; } }
    }
    nloc = mine > 0u ? mine : 1u; nx = cnt > 0u ? cnt : 1u;
}
__device__ __forceinline__ void xcd_barrier(const XcdBarrier& b) {
    asm volatile("s_waitcnt vmcnt(0)" ::: "memory");
    __syncthreads();
    if (threadIdx.x == 0) {
        unsigned* bar = b.bar;
        __builtin_amdgcn_s_waitcnt(0);
        unsigned nloc = b.st[0], nx = b.st[1];
        if (nloc == 0u) { xcd_barrier_complete(bar, b.x, nloc, nx); b.st[0] = nloc; b.st[1] = nx; }
        const unsigned old = xb_add(&bar[XB_XSUB(b.x)], 1u);
        const unsigned gen = old / nloc;
        if (old + 1u == (gen + 1u) * nloc) {
            __builtin_amdgcn_fence(__ATOMIC_RELEASE, "agent");
            asm volatile("s_waitcnt vmcnt(0)" ::: "memory");
            const unsigned og = xb_add(&bar[XB_TOP], 1u);
            const unsigned tg = og / nx;
            if (og + 1u == (tg + 1u) * nx) xb_add(&bar[XB_TOPGEN], 1u);
            else XB_SPIN(xb_ld(&bar[XB_TOPGEN]) == tg, bar);
            __builtin_amdgcn_fence(__ATOMIC_ACQUIRE, "agent");
            xb_add(&bar[XB_XGEN(b.x)], 1u);
            asm volatile("s_waitcnt vmcnt(0)" ::: "memory");
        } else {
            XB_SPIN(xb_ld(&bar[XB_XGEN(b.x)]) == gen, bar);
            __builtin_amdgcn_fence(__ATOMIC_ACQUIRE, "agent");
            asm volatile("s_waitcnt vmcnt(0)" ::: "memory");
        }
    }
    __syncthreads();
}

struct Args { const float* in[16]; float* out; unsigned char* ws; int ph_lo, ph_hi; };

__device__ __forceinline__ void norm_rows_bf16(const float* X, bf16_t* H, const float* gam, const float* modl, int gw, int NGW, int lane) {
    for (int m0 = gw * 4; m0 < MT; m0 += NGW * 4) {
        const int b = m0 >> 13;
        f32x4 v[4][4]; float ss[4];
#pragma unroll
        for (int r = 0; r < 4; ++r) { const f32x4* xr = (const f32x4*)(X + (size_t)(m0 + r) * DM) + lane;
#pragma unroll
            for (int j = 0; j < 4; ++j) v[r][j] = xr[64 * j]; }
#pragma unroll
        for (int r = 0; r < 4; ++r) { float s = 0.f;
#pragma unroll
            for (int j = 0; j < 4; ++j) s += (v[r][j][0] * v[r][j][0] + v[r][j][1] * v[r][j][1]) + (v[r][j][2] * v[r][j][2] + v[r][j][3] * v[r][j][3]);
            ss[r] = 1.0f / sqrtf(wave_sum(s) * (1.0f / DM) + RMS_EPS); }
        const float* mb = modl + (size_t)b * 3072;
#pragma unroll
        for (int j = 0; j < 4; ++j) { const int col = 256 * j + 4 * lane;
            const f32x4 gg = *(const f32x4*)(gam + col), sh = *(const f32x4*)(mb + col), sc = *(const f32x4*)(mb + 1024 + col);
            const f32x4 mul = gg * (sc + 1.0f);
#pragma unroll
            for (int r = 0; r < 4; ++r) { const f32x4 o = v[r][j] * ss[r] * mul + sh;
                u32x2 w; w.x = pk2(o[0], o[1]); w.y = pk2(o[2], o[3]);
                *(u32x2*)(H + tiled_elem(m0 + r, col, DM / 64)) = w; } }
    }
}

__global__ void __launch_bounds__(512, 2) fwd_megakernel(Args args) {
    extern __shared__ __attribute__((aligned(16))) unsigned char lds_raw[];
    LAS unsigned char* lds = (LAS unsigned char*)lds_raw;
    cg::grid_group grid = cg::this_grid();
    const int tid = threadIdx.x, lane = tid & 63, wave = __builtin_amdgcn_readfirstlane(tid >> 6);
    const int G = gridDim.x, bx = blockIdx.x, gw = bx * 8 + wave, NGW = G * 8;
    unsigned char* ws = args.ws;
    const float* x = args.in[0]; const float* cvec = args.in[1]; const float* mod_w = args.in[2]; const float* mod_b = args.in[3]; const float* norm_g = args.in[4];
    const float* a_w_in = args.in[5]; const float* a_conv_w = args.in[6]; const float* a_conv_b = args.in[7]; const float* a_w_out = args.in[8];
    const float* b_w_in = args.in[9]; const float* b_ln_g = args.in[10]; const float* b_ln_b = args.in[11]; const float* b_w_s = args.in[12]; const float* b_b_s = args.in[13];
    const float* b_w_out = args.in[14]; const float* final_g = args.in[15];
    float* out = args.out;
    float* MOD = (float*)(ws + WS_MOD); f32x2* PART = (f32x2*)(ws + WS_PART);
    float* HG = (float*)(ws + WS_HG); float* GG = (float*)(ws + WS_GG); float* PC = (float*)(ws + WS_PC);
    bf16_t* WSb = (bf16_t*)(ws + WS_WS); bf16_t* W1t = (bf16_t*)(ws + WS_W1); bf16_t* W2t = (bf16_t*)(ws + WS_W2); bf16_t* W3t = (bf16_t*)(ws + WS_W3); bf16_t* W4t = (bf16_t*)(ws + WS_W4);
    bf16_t* H = (bf16_t*)(ws + WS_H); bf16_t* Y = (bf16_t*)(ws + WS_Y); bf16_t* VT = (bf16_t*)(ws + WS_VT);
    const int lo = args.ph_lo, hi = args.ph_hi;
    if (lo < 0) grid.sync();
#define IN(k) (lo <= (k) && (k) < hi)
#define SEAM(k) do { if (IN(k) && IN((k) + 1)) xcd_barrier(xbar); } while (0)
    volatile LAS unsigned* MISC = (volatile LAS unsigned*)(lds + EPI_OFF + 8192);
    if (tid < 2) MISC[tid] = 0u;
    __syncthreads();
    XcdBarrier xbar = xcd_barrier_post((unsigned*)(ws + WS_CTL) + 4096, MISC);

    if (IN(0)) {
        LAS float* sc = (LAS float*)lds;
        for (int it = bx; it < 384; it += G) {
            const int l = it / 192, r = it % 192, ks = r / 6, cgp = r % 6;
            __syncthreads();
            if (tid < 128) { const int b = tid >> 5, kk = tid & 31; const float cv = cvec[b * DM + ks * 32 + kk]; sc[tid] = cv / (1.0f + __expf(-cv)); }
            __syncthreads();
            const int n = cgp * 512 + tid;
            const float* w = mod_w + ((size_t)l * DM + ks * 32) * 3072 + n;
            float wv[32];
#pragma unroll
            for (int kk = 0; kk < 32; ++kk) wv[kk] = w[(size_t)kk * 3072];
            float a0 = 0.f, a1 = 0.f, a2 = 0.f, a3 = 0.f;
#pragma unroll
            for (int kk = 0; kk < 32; ++kk) { a0 += sc[kk] * wv[kk]; a1 += sc[32 + kk] * wv[kk]; a2 += sc[64 + kk] * wv[kk]; a3 += sc[96 + kk] * wv[kk]; }
            if (ks == 0) { const float bv = mod_b[l * 3072 + n]; a0 += bv; a1 += bv; a2 += bv; a3 += bv; }
            float* mp = MOD + (size_t)l * 4 * 3072 + n;
            atomicAdd(mp, a0); atomicAdd(mp + 3072, a1); atomicAdd(mp + 2 * 3072, a2); atomicAdd(mp + 3 * 3072, a3);
        }
        __syncthreads();
        LAS float* scr = (LAS float*)(lds + wave * 16384);
        constexpr int I1 = (DM / 64) * (4 * DE / 32), I2 = (DE / 64) * (DM / 32), I3 = (DM / 64) * (3 * DE / 32), I4 = I2;
        for (int it = gw; it < I1 + I2 + I3 + I4; it += NGW) {
            int r = it;
            if (r < I1) { p0_transpose_item(a_w_in, DM, 4 * DE, W1t, scr, r, lane); continue; } r -= I1;
            if (r < I2) { p0_transpose_item(a_w_out, DE, DM, W2t, scr, r, lane); continue; } r -= I2;
            if (r < I3) { p0_transpose_item(b_w_in, DM, 3 * DE, W3t, scr, r, lane); continue; } r -= I3;
            p0_transpose_item(b_w_out, DE, DM, W4t, scr, r, lane);
        }
        for (int i = bx * 512 + tid; i < 8 * 128 * 128; i += G * 512) { const int s = i & 127, t = (i >> 7) & 127, gq = i >> 14;
            WSb[(((gq * 8 + (t >> 4)) * 4 + (s >> 5)) * 64 + (t & 15) * 4 + ((s >> 3) & 3)) * 8 + (s & 7)] = (bf16_t)f2bf(s <= t ? b_w_s[i] : 0.0f); }
    }
    SEAM(0);
    if (IN(1)) norm_rows_bf16(x, H, norm_g, MOD, gw, NGW, lane);
    SEAM(1);
    if (IN(2)) {
        GemmDesc g{H, W1t, DM, (size_t)256 * DM * 2, (size_t)128 * DM * 2, (size_t)128 * DM * 2, (size_t)4096 * DM * 2, MT / 256, 32, 1};
        StaticOrder S; S.init(g.nM, g.nN, G, bx);
        EpiConv E{Y, a_conv_w, a_conv_b, HG, GG, PC};
        gemm_phase<EpiConv>(lds, g, S, E);
    }
    if (IN(2) && IN(4)) xcd_barrier(xbar);
    if (IN(4)) {
        GemmDesc g{Y, W2t, DE, (size_t)256 * DE * 2, (size_t)128 * DE * 2, (size_t)256 * DE * 2, (size_t)128 * DE * 2, MT / 256, 4, 0};
        StaticOrder S; S.init(g.nM, g.nN, G, bx);
        { Unit fu;
          for (int ui = 0; S.next(ui, fu); ++ui) {
            const int pm = fu.pm; if ((pm & 31) == 0) continue;
            for (int it = tid; it < 1024; it += 512) {
                const int i = it >> 9, j = (it & 511) * 4;
                const f32x4 g = *(const f32x4*)(GG + ((size_t)(pm * 2 + i)) * 2048 + j), pc = *(const f32x4*)(PC + ((size_t)(pm * 2 + i)) * 2048 + j);
                const f32x4 c15 = *(const f32x4*)(HG + ((size_t)((pm - 1) * 2 + 1)) * 2048 + j), c14 = *(const f32x4*)(HG + ((size_t)((pm - 1) * 2 + 0)) * 2048 + j);
                const f32x4 w0 = *(const f32x4*)(a_conv_w + j), w1 = *(const f32x4*)(a_conv_w + 2048 + j);
                const f32x4 add = (i == 0) ? (w1 * c15 + w0 * c14) : (w0 * c15);
                const f32x4 yv = g * (pc + add);
                u32x2 w; w.x = pk2(yv[0], yv[1]); w.y = pk2(yv[2], yv[3]);
                *(u32x2*)(Y + tiled_elem(pm * 256 + i, j, DE / 64)) = w;
            }
          }
          asm volatile("s_waitcnt vmcnt(0)" ::: "memory"); __syncthreads(); }
        EpiResNorm<0> E{x, out, H, MOD + 2048, norm_g + DM, MOD + 4 * 3072, (float*)(ws + WS_XS), (unsigned*)(ws + WS_CTL) + 8192, (bf16_t*)(ws + WS_X1)};
        gemm_phase<EpiResNorm<0>>(lds, g, S, E);
    }
    if (IN(4) && IN(6)) xcd_barrier(xbar);
    if (IN(6)) {
        GemmDesc g{W3t + (size_t)2048 * DM, H, DM, (size_t)256 * DM * 2, (size_t)128 * DM * 2, (size_t)256 * DM * 2, (size_t)128 * DM * 2, 8, MT / 256, 0};
        StaticOrder S; S.init(g.nM, g.nN, G, bx);
        EpiV E{VT, PART};
        gemm_phase<EpiV>(lds, g, S, E);
    }
    SEAM(6);
    if (IN(7)) {
        GemmDesc g{H, W3t, DM, (size_t)256 * DM * 2, (size_t)128 * DM * 2, (size_t)128 * DM * 2, (size_t)4096 * DM * 2, MT / 256, 16, 0};
        StaticOrder S; S.init(g.nM, g.nN, G, bx);
        EpiMix E{Y, VT, WSb, PART, b_ln_g, b_ln_b, b_b_s};
        gemm_phase<EpiMix>(lds, g, S, E);
    }
    SEAM(7);
    if (IN(8)) {
        GemmDesc g{Y, W4t, DE, (size_t)256 * DE * 2, (size_t)128 * DE * 2, (size_t)256 * DE * 2, (size_t)128 * DE * 2, MT / 256, 4, 0};
        StaticOrder S; S.init(g.nM, g.nN, G, bx);
        EpiResNorm<1> E{out, out, nullptr, MOD + 4 * 3072 + 2048, final_g, nullptr, (float*)(ws + WS_XS) + 128 * 4 * 256, (unsigned*)(ws + WS_CTL) + 8192 + 128 * 64, (bf16_t*)(ws + WS_X1)};
        gemm_phase<EpiResNorm<1>>(lds, g, S, E);
    }
#undef IN
#undef SEAM
}

#ifndef MK_MULTI
#define MK_MULTI 0
#endif
extern "C" void kernel_launch(void* const* d_in, const int* in_sizes, int n_in, void* d_out, int out_size, void* d_ws, size_t ws_size, hipStream_t stream) {
    static int grid = 0;
    if (grid == 0) {
        if (n_in != 16 || out_size != MT * DM || ws_size < WS_END) { fprintf(stderr, "kernel_launch: unexpected shapes (n_in %d out %d ws %zu)\n", n_in, out_size, ws_size); grid = -1; return; }
        int dev = 0, cus = 0, per_cu = 0;
        hipGetDevice(&dev); hipDeviceGetAttribute(&cus, hipDeviceAttributeMultiprocessorCount, dev);
        if (hipFuncSetAttribute((const void*)fwd_megakernel, hipFuncAttributeMaxDynamicSharedMemorySize, LDS_BYTES) != hipSuccess) { fprintf(stderr, "kernel_launch: hipFuncSetAttribute failed\n"); grid = -1; return; }
        if (hipOccupancyMaxActiveBlocksPerMultiprocessor(&per_cu, (const void*)fwd_megakernel, 512, LDS_BYTES) != hipSuccess || per_cu < 1) { fprintf(stderr, "kernel_launch: occupancy query says %d\n", per_cu); per_cu = 1; }
        (void)hipGetLastError();
        grid = cus * per_cu;
    }
    if (grid < 0) return;
    hipMemsetAsync((char*)d_ws + WS_CTL, 0, CTL_ZERO_BYTES, stream);
    Args a{};
    for (int i = 0; i < 16; ++i) a.in[i] = (const float*)d_in[i];
    a.out = (float*)d_out; a.ws = (unsigned char*)d_ws;
#if MK_MULTI
    for (int p = 0; p < 10; ++p) { a.ph_lo = p; a.ph_hi = p + 1; hipLaunchKernelGGL(fwd_megakernel, dim3(grid), dim3(512), LDS_BYTES, stream, a); }
#else
    a.ph_lo = 0; a.ph_hi = 10;
    void* kargs[] = {&a};
    hipError_t e = hipLaunchCooperativeKernel((const void*)fwd_megakernel, dim3(grid), dim3(512), kargs, LDS_BYTES, stream);
    if (e != hipSuccess) fprintf(stderr, "cooperative launch failed: %s (grid %d)\n", hipGetErrorString(e), grid);
#endif
}
```

```cpp
#include <hip/hip_runtime.h>
#include <hip/hip_cooperative_groups.h>
#include <cstdio>
#include <cstdint>
namespace cg = cooperative_groups;

#define LAS __attribute__((address_space(3)))
typedef unsigned short bf16_t;
typedef short bf16x8 __attribute__((ext_vector_type(8)));
typedef float f32x4 __attribute__((ext_vector_type(4)));
typedef float f32x2 __attribute__((ext_vector_type(2)));
typedef unsigned u32x4 __attribute__((ext_vector_type(4)));
typedef unsigned u32x2 __attribute__((ext_vector_type(2)));

constexpr int DM = 1024, NB = 4, SEQ = 8192, DE = 2048, MT = NB * SEQ;
constexpr float RMS_EPS = 1e-6f, LN_EPS = 1e-5f;
constexpr int YP = DE;

constexpr size_t MiB = 1u << 20;
constexpr size_t WS_CTL = 0, CTL_ZERO_BYTES = 256 * 1024;
constexpr size_t WS_MOD = 128 * 1024;
constexpr size_t WS_PART = 46 * MiB;
constexpr size_t WS_XS = 2 * MiB;
constexpr size_t WS_HG = 3 * MiB, WS_GG = 5 * MiB, WS_PC = 7 * MiB;
constexpr size_t WS_WS = 9 * MiB;
constexpr size_t WS_W1 = 10 * MiB;
constexpr size_t WS_W2 = 26 * MiB;
constexpr size_t WS_W3 = 30 * MiB;
constexpr size_t WS_W4 = 42 * MiB;
constexpr size_t WS_H = 48 * MiB;
constexpr size_t WS_Y = 112 * MiB;
constexpr size_t WS_VT = 248 * MiB;
constexpr size_t WS_X1 = 376 * MiB;
constexpr size_t WS_END = 440 * MiB;

constexpr int STAGE_BYTES = 131072, EPI_OFF = 131072, LDS_BYTES = 147456;

constexpr int BM = 256, BK = 64, HALF = 128, HTB = HALF * BK * 2, NXCD = 8, WGM = 8;
__host__ __device__ __forceinline__ int lds_byte(int r, int c) { const int st = (r >> 4) * 2 + (c >> 5), rr = r & 15, cc = c & 31, ob = rr * 64 + cc * 2; return st * 1024 + (ob ^ (((ob >> 9) & 1) << 5)); }
__host__ __device__ __forceinline__ void stage_rc(int b, int& R, int& C) { const int st = b / 1024, sb = b % 1024, swz = sb ^ (((sb >> 9) & 1) << 5); R = (st >> 1) * 16 + swz / 64; C = (st & 1) * 32 + (swz % 64) / 2; }
__host__ __device__ __forceinline__ int perm32(int rho) { const int n = rho >> 4, i = rho & 15; return 8 * (i >> 2) + 4 * n + (i & 3); }

__host__ __device__ __forceinline__ size_t tiled_elem(int row, int col, int nKt) { return (size_t)((row >> 7) * nKt + (col >> 6)) * 8192 + (size_t)(lds_byte(row & 127, col & 63) >> 1); }
struct Unit { int pm, pn, fresh; };
struct GemmDesc { const bf16_t* A; const bf16_t* Bt; int K; size_t tstepA, hstepA, tstepB, hstepB; int nM, nN; int pnHalf; };

struct StaticOrder {
    int nM, nN, nwg, G, c;
    __device__ void init(int nM_, int nN_, int G_, int c_) { nM = nM_; nN = nN_; nwg = nM * nN; G = G_; c = c_; }
    __device__ bool next(int i, Unit& u) const {
        const long L = (long)i * G + c; if (L >= nwg) return false;
        int wgid = (int)L; { const int q = nwg / NXCD, r = nwg % NXCD, xcd = wgid % NXCD, off = wgid / NXCD; wgid = (xcd < r ? xcd * (q + 1) : r * (q + 1) + (xcd - r) * q) + off; }
        const int nig = WGM * nN, gid = wgid / nig, fm = gid * WGM, gsz = (nM - fm) < WGM ? (nM - fm) : WGM;
        u.pm = fm + ((wgid % nig) % gsz); u.pn = (wgid % nig) / gsz; return true;
    }
};

__device__ __forceinline__ unsigned cvt_pk_bf16(float lo, float hi) { unsigned r; asm volatile("v_cvt_pk_bf16_f32 %0, %1, %2" : "=v"(r) : "v"(lo), "v"(hi)); return r; }
__device__ __forceinline__ f32x2 gelu_pk(f32x2 v) {
    const f32x2 av = __builtin_elementwise_abs(v), d = av * 0.2316418882f + 1.0f;
    f32x2 t; t.x = __builtin_amdgcn_rcpf(d.x); t.y = __builtin_amdgcn_rcpf(d.y);
    f32x2 q = t * 0.5307027145f + (-0.7265760135f); q = q * t + 0.7107068705f; q = q * t + (-0.142248368f); q = q * t + 0.127414796f; q = q * t;
    const f32x2 s = (v * v) * (-0.72134752044f);
    f32x2 e; e.x = __builtin_amdgcn_exp2f(s.x); e.y = __builtin_amdgcn_exp2f(s.y);
    const f32x2 c = 0.5f - q * e;
    return av * c + v * 0.5f;
}
__device__ __forceinline__ f32x4 gelu4(f32x4 v) { const f32x2 a = gelu_pk((f32x2){v[0], v[1]}), b = gelu_pk((f32x2){v[2], v[3]}); return (f32x4){a.x, a.y, b.x, b.y}; }
__device__ __forceinline__ float silu1(float z) { return z * __builtin_amdgcn_rcpf(1.0f + __builtin_amdgcn_exp2f(-1.4426950408889634f * z)); }
__device__ __forceinline__ f32x2 silu2(f32x2 z) {
    const f32x2 a = z * (-1.4426950408889634f);
    f32x2 e; e.x = __builtin_amdgcn_exp2f(a.x); e.y = __builtin_amdgcn_exp2f(a.y);
    const f32x2 d = e + 1.0f;
    f32x2 r; r.x = __builtin_amdgcn_rcpf(d.x); r.y = __builtin_amdgcn_rcpf(d.y);
    return z * r;
}
__device__ __forceinline__ f32x4 silu4(f32x4 z) { const f32x2 a = silu2((f32x2){z[0], z[1]}), b = silu2((f32x2){z[2], z[3]}); return (f32x4){a.x, a.y, b.x, b.y}; }
#define EPI_BARRIER() do { asm volatile("s_waitcnt lgkmcnt(0)" ::: "memory"); __builtin_amdgcn_s_barrier(); asm volatile("" ::: "memory"); } while (0)


struct EpiConv {
    static __host__ __device__ __forceinline__ unsigned boff(int R, int C, int nKt) { return (unsigned)(((R >> 4) & 1) * 16 * nKt) * 16384u + (unsigned)(R >> 5) * 2048u + (unsigned)lds_byte(R & 15, C); }
    bf16_t* Y; const float* cw; const float* cb; float* HG; float* GG; float* PC;
    __device__ __forceinline__ void operator()(f32x4 (&acc)[2][2][4][2], const Unit& u, int wr, int wc, int fr, int fq, LAS unsigned char* lds, int tid) const {
        LAS float* halo = (LAS float*)(lds + EPI_OFF);
        const int jl = 16 * wc + 4 * fq, j = 64 * u.pn + jl;
#pragma unroll
        for (int ai = 0; ai < 2; ++ai)
#pragma unroll
            for (int m = 0; m < 4; ++m) {
                const f32x4 Bg = acc[ai][0][m][0], Cg = acc[ai][0][m][1], Xi = acc[ai][1][m][0], Z = acc[ai][1][m][1];
                const f32x4 cx = Cg * Xi, g = silu4(Z) * Bg;
                acc[ai][0][m][1] = cx; acc[ai][1][m][1] = g;
                const int G = ai * 8 + wr * 4 + m;
                if (fr >= 14) {
                    *(LAS f32x4*)(halo + (G * 2 + (fr - 14)) * 64 + jl) = cx;
                    if (G == 15) *(f32x4*)(HG + ((size_t)(u.pm * 2 + (fr - 14))) * 2048 + j) = cx;
                }
            }
        EPI_BARRIER();
        const f32x4 w0 = *(const f32x4*)(cw + j), w1 = *(const f32x4*)(cw + 2048 + j), w2 = *(const f32x4*)(cw + 4096 + j), cbv = *(const f32x4*)(cb + j);
#pragma unroll
        for (int ai = 0; ai < 2; ++ai)
#pragma unroll
            for (int m = 0; m < 4; ++m) {
                const int G = ai * 8 + wr * 4 + m;
                const f32x4 cx = acc[ai][0][m][1], g = acc[ai][1][m][1];
                f32x4 h1 = (f32x4){0.f, 0.f, 0.f, 0.f}, hB = h1;
                if (G > 0) { h1 = *(const LAS f32x4*)(halo + ((G - 1) * 2 + 1) * 64 + jl); hB = *(const LAS f32x4*)(halo + ((G - 1) * 2 + (fr < 1 ? 0 : 1)) * 64 + jl); }
                f32x4 p1, p2;
#pragma unroll
                for (int e = 0; e < 4; ++e) { p1[e] = __shfl_up(cx[e], 1, 16); p2[e] = __shfl_up(cx[e], 2, 16); }
                if (fr < 1) p1 = h1;
                if (fr < 2) p2 = hB;
                const f32x4 pc = cbv + w2 * cx + w1 * p1 + w0 * p2, yv = g * pc;
                const size_t row = (size_t)u.pm * 256 + 16 * G + fr;
                u32x2 w; w.x = cvt_pk_bf16(yv[0], yv[1]); w.y = cvt_pk_bf16(yv[2], yv[3]);
                *(u32x2*)(Y + tiled_elem((int)row, j, DE / 64)) = w;
                if (G == 0 && fr < 2) { *(f32x4*)(GG + ((size_t)(u.pm * 2 + fr)) * 2048 + j) = g; *(f32x4*)(PC + ((size_t)(u.pm * 2 + fr)) * 2048 + j) = pc; }
            }
    }
};

struct EpiRes {
    static __host__ __device__ __forceinline__ unsigned boff(int R, int C, int nKt) { return (unsigned)lds_byte(R, C); }
    const float* xin; float* out; const float* gate;
    __device__ __forceinline__ void operator()(f32x4 (&acc)[2][2][4][2], const Unit& u, int wr, int wc, int fr, int fq, LAS unsigned char* lds, int tid) const {
        const int row0 = u.pm * BM + wr * 64 + fr, col0 = u.pn * BM + wc * 32 + 4 * fq;
        const float* gp = gate + (size_t)(u.pm >> 5) * 3072 + col0;
        f32x4 gv[2][2];
#pragma unroll
        for (int bj = 0; bj < 2; ++bj)
#pragma unroll
            for (int n = 0; n < 2; ++n) gv[bj][n] = *(const f32x4*)(gp + bj * HALF + n * 16);
#pragma unroll
        for (int ai = 0; ai < 2; ++ai)
#pragma unroll
            for (int m = 0; m < 4; ++m) { const size_t off = (size_t)(row0 + ai * HALF + m * 16) * DM + col0;
#pragma unroll
                for (int bj = 0; bj < 2; ++bj)
#pragma unroll
                    for (int n = 0; n < 2; ++n) { const f32x4 xv = *(const f32x4*)(xin + off + bj * HALF + n * 16); *(f32x4*)(out + off + bj * HALF + n * 16) = xv + gv[bj][n] * acc[ai][bj][m][n]; }
                if (m & 1) asm volatile("" ::: "memory"); }
    }
};

template <int MODE> struct EpiResNorm {
    static __host__ __device__ __forceinline__ unsigned boff(int R, int C, int nKt) { return (unsigned)lds_byte((R & ~31) + perm32(R & 31), C); }
    const float* xin; float* out; bf16_t* Hn; const float* gate; const float* gam; const float* modl; float* XS; unsigned* cnt; bf16_t* X1;
    __device__ __forceinline__ void operator()(f32x4 (&acc)[2][2][4][2], const Unit& u_, int wr_, int wc_, int fr_, int fq_, LAS unsigned char* lds, int tid_) const {
        Unit u; u.pm = u_.pm; u.pn = u_.pn; asm volatile("" : "+s"(u.pm), "+s"(u.pn));
        int tid = tid_; asm volatile("" : "+v"(tid));
        const int wid = __builtin_amdgcn_readfirstlane(tid >> 6), wr = wid >> 2, wc = wid & 3, fr = tid & 15, fq = (tid >> 4) & 3;
        LAS float* P = (LAS float*)(lds + EPI_OFF);
        LAS float* S = (LAS float*)(lds + EPI_OFF + 4096);
        const int b = u.pm >> 5;
        const int row0 = u.pm * BM + wr * 64 + fr, col0 = u.pn * BM + wc * 32 + 8 * fq;
        const unsigned x1base = (unsigned)(((u.pm * 4 + u.pn) * 8 + wid) * 16 * 512) + (unsigned)(tid & 63) * 8u;
        {
            f32x4 gv[2][2];
#pragma unroll
            for (int bj = 0; bj < 2; ++bj)
#pragma unroll
                for (int n = 0; n < 2; ++n) gv[bj][n] = *(const f32x4*)(gate + (size_t)b * 3072 + col0 + bj * HALF + 4 * n);
            if (MODE == 0) {
#pragma unroll
            for (int ai = 0; ai < 2; ++ai) {
                f32x4 xt[4][2][2];
#pragma unroll
                for (int m = 0; m < 4; ++m) { const unsigned off = (unsigned)(row0 + ai * HALF + m * 16) * DM + col0;
#pragma unroll
                    for (int bj = 0; bj < 2; ++bj)
#pragma unroll
                        for (int n = 0; n < 2; ++n) xt[m][bj][n] = *(const f32x4*)(xin + off + bj * HALF + 4 * n); }
#pragma unroll
                for (int m = 0; m < 4; ++m) {
#pragma unroll
                    for (int bj = 0; bj < 2; ++bj)
#pragma unroll
                        for (int n = 0; n < 2; ++n) acc[ai][bj][m][n] = xt[m][bj][n] + gv[bj][n] * acc[ai][bj][m][n];
                    asm volatile("" : "+v"(acc[ai][0][m][0]), "+v"(acc[ai][0][m][1]), "+v"(acc[ai][1][m][0]), "+v"(acc[ai][1][m][1]));
                }
                asm volatile("" ::: "memory"); __builtin_amdgcn_sched_barrier(0);
            }
            } else {
#pragma unroll
            for (int ai = 0; ai < 2; ++ai) {
                u32x4 xb[4][2];
#pragma unroll
                for (int m = 0; m < 4; ++m) {
#pragma unroll
                    for (int bj = 0; bj < 2; ++bj) xb[m][bj] = *(const u32x4*)(X1 + x1base + (unsigned)(((ai * 4 + m) * 2 + bj) * 512)); }
#pragma unroll
                for (int m = 0; m < 4; ++m) {
#pragma unroll
                    for (int bj = 0; bj < 2; ++bj) { const u32x4 w = xb[m][bj];
                        const f32x4 xa = (f32x4){__uint_as_float(w.x << 16), __uint_as_float(w.x & 0xffff0000u), __uint_as_float(w.y << 16), __uint_as_float(w.y & 0xffff0000u)};
                        const f32x4 xc = (f32x4){__uint_as_float(w.z << 16), __uint_as_float(w.z & 0xffff0000u), __uint_as_float(w.w << 16), __uint_as_float(w.w & 0xffff0000u)};
                        acc[ai][bj][m][0] = xa + gv[bj][0] * acc[ai][bj][m][0]; acc[ai][bj][m][1] = xc + gv[bj][1] * acc[ai][bj][m][1]; }
                    asm volatile("" : "+v"(acc[ai][0][m][0]), "+v"(acc[ai][0][m][1]), "+v"(acc[ai][1][m][0]), "+v"(acc[ai][1][m][1]));
                }
                asm volatile("" ::: "memory"); __builtin_amdgcn_sched_barrier(0);
            }
            }
        }
#pragma unroll
        for (int ai = 0; ai < 2; ++ai)
#pragma unroll
            for (int m = 0; m < 4; ++m) { float ss = 0.f;
#pragma unroll
                for (int bj = 0; bj < 2; ++bj)
#pragma unroll
                    for (int n = 0; n < 2; ++n) { const f32x4 v = acc[ai][bj][m][n]; ss += (v[0] * v[0] + v[1] * v[1]) + (v[2] * v[2] + v[3] * v[3]); }
                ss += __shfl_xor(ss, 16); ss += __shfl_xor(ss, 32);
                if (fq == 0) P[(ai * HALF + wr * 64 + m * 16 + fr) * 4 + wc] = ss; }
        EPI_BARRIER();
        if (wid < 4) {
            const f32x4 p = *(const LAS f32x4*)(P + tid * 4);
            __hip_atomic_store(XS + ((size_t)(u.pm * 4 + u.pn)) * 256 + tid, (p[0] + p[1]) + (p[2] + p[3]), __ATOMIC_RELAXED, __HIP_MEMORY_SCOPE_AGENT);
            asm volatile("s_waitcnt vmcnt(0)" ::: "memory");
            if ((tid & 63) == 0) __hip_atomic_fetch_add(cnt + 64 * u.pm, 1u, __ATOMIC_RELAXED, __HIP_MEMORY_SCOPE_AGENT);
        }
        if (MODE == 0) {
#pragma unroll
            for (int ai = 0; ai < 2; ++ai)
#pragma unroll
                for (int m = 0; m < 4; ++m) {
#pragma unroll
                    for (int bj = 0; bj < 2; ++bj) { const f32x4 a = acc[ai][bj][m][0], c = acc[ai][bj][m][1];
                        u32x4 w; w.x = cvt_pk_bf16(a[0], a[1]); w.y = cvt_pk_bf16(a[2], a[3]); w.z = cvt_pk_bf16(c[0], c[1]); w.w = cvt_pk_bf16(c[2], c[3]);
                        *(u32x4*)(X1 + x1base + (unsigned)(((ai * 4 + m) * 2 + bj) * 512)) = w; } }
        }
        if (wid == 0) {
            unsigned sp = 0;
            while ((unsigned)__builtin_amdgcn_readfirstlane(__hip_atomic_load(cnt + 64 * u.pm, __ATOMIC_RELAXED, __HIP_MEMORY_SCOPE_AGENT)) < 16u) { __builtin_amdgcn_s_sleep(1); if (++sp > (1u << 20)) break; }
            __builtin_amdgcn_fence(__ATOMIC_ACQUIRE, "agent");
            asm volatile("s_waitcnt vmcnt(0)" ::: "memory");
        }
        EPI_BARRIER();
        if (wid < 4) { float t = 0.f;
#pragma unroll
            for (int p = 0; p < 4; ++p) t += __hip_atomic_load(XS + ((size_t)(u.pm * 4 + p)) * 256 + tid, __ATOMIC_RELAXED, __HIP_MEMORY_SCOPE_AGENT);
            S[tid] = 1.0f / sqrtf(t * (1.0f / DM) + RMS_EPS); }
        EPI_BARRIER();
#pragma unroll
        for (int bj = 0; bj < 2; ++bj) {
            f32x4 mul[2], sh[2];
#pragma unroll
            for (int n = 0; n < 2; ++n) { const int c = col0 + bj * HALF + 4 * n; const f32x4 gg = *(const f32x4*)(gam + c);
                if (MODE == 0) { const f32x4 sc = *(const f32x4*)(modl + (size_t)b * 3072 + 1024 + c); mul[n] = gg * (sc + 1.0f); sh[n] = *(const f32x4*)(modl + (size_t)b * 3072 + c); }
                else { mul[n] = gg; sh[n] = (f32x4){0.f, 0.f, 0.f, 0.f}; } }
#pragma unroll
            for (int ai = 0; ai < 2; ++ai)
#pragma unroll
                for (int m = 0; m < 4; ++m) { const int r = ai * HALF + wr * 64 + m * 16 + fr; const float rs = S[r]; const unsigned off = (unsigned)(u.pm * BM + r) * DM + col0 + bj * HALF;
                    const f32x4 o0 = acc[ai][bj][m][0] * rs * mul[0] + sh[0], o1 = acc[ai][bj][m][1] * rs * mul[1] + sh[1];
                    if (MODE == 0) { u32x4 w; w.x = cvt_pk_bf16(o0[0], o0[1]); w.y = cvt_pk_bf16(o0[2], o0[3]); w.z = cvt_pk_bf16(o1[0], o1[1]); w.w = cvt_pk_bf16(o1[2], o1[3]); *(u32x4*)(Hn + tiled_elem(u.pm * BM + r, col0 + bj * HALF, DM / 64)) = w; }
                    else { *(f32x4*)(out + off) = o0; *(f32x4*)(out + off + 4) = o1; } }
            asm volatile("" ::: "memory");
        }
    }
};

__device__ __forceinline__ float row16_sum(float x) {
    x += __builtin_bit_cast(float, __builtin_amdgcn_update_dpp(0, __builtin_bit_cast(int, x), 0x128, 0xf, 0xf, true));
    x += __builtin_bit_cast(float, __builtin_amdgcn_update_dpp(0, __builtin_bit_cast(int, x), 0x124, 0xf, 0xf, true));
    x += __builtin_bit_cast(float, __builtin_amdgcn_update_dpp(0, __builtin_bit_cast(int, x), 0x122, 0xf, 0xf, true));
    x += __builtin_bit_cast(float, __builtin_amdgcn_update_dpp(0, __builtin_bit_cast(int, x), 0x121, 0xf, 0xf, true));
    return x;
}
struct EpiV {
    static __host__ __device__ __forceinline__ unsigned boff(int R, int C, int nKt) { return (unsigned)lds_byte((R & ~31) + perm32(R & 31), C); }
    bf16_t* VT; f32x2* PART;
    __device__ __forceinline__ void operator()(f32x4 (&acc)[2][2][4][2], const Unit& u, int wr, int wc, int fr, int fq, LAS unsigned char* lds, int tid) const {
        LAS float* red = (LAS float*)(lds + EPI_OFF);
#pragma unroll
        for (int bj = 0; bj < 2; ++bj) {
            const int chunk = 2 * u.pn + bj;
            f32x4 s0 = (f32x4){0.f, 0.f, 0.f, 0.f}, s1 = s0, q0 = s0, q1 = s0;
#pragma unroll
            for (int ai = 0; ai < 2; ++ai)
#pragma unroll
                for (int m = 0; m < 4; ++m) {
                    const int f = 256 * u.pm + 128 * ai + 64 * wr + 16 * m + fr;
                    const f32x4 v0 = gelu4(acc[ai][bj][m][0]), v1 = gelu4(acc[ai][bj][m][1]);
                    s0 += v0; s1 += v1; q0 += v0 * v0; q1 += v1 * v1;
                    u32x4 w; w.x = cvt_pk_bf16(v0[0], v0[1]); w.y = cvt_pk_bf16(v0[2], v0[3]); w.z = cvt_pk_bf16(v1[0], v1[1]); w.w = cvt_pk_bf16(v1[2], v1[3]);
                    *(u32x4*)(VT + ((((size_t)chunk * 128 + (f >> 4)) * 4 + wc) * 64 + fr * 4 + fq) * 8) = w;
                }
#pragma unroll
            for (int e = 0; e < 4; ++e) { s0[e] = row16_sum(s0[e]); s1[e] = row16_sum(s1[e]); q0[e] = row16_sum(q0[e]); q1[e] = row16_sum(q1[e]); }
            if (fr == 0) {
                LAS f32x4* rp = (LAS f32x4*)(red + ((size_t)((wr * 2 + bj) * 128) + 32 * wc + 8 * fq) * 2);
                rp[0] = (f32x4){s0[0], q0[0], s0[1], q0[1]}; rp[1] = (f32x4){s0[2], q0[2], s0[3], q0[3]};
                rp[2] = (f32x4){s1[0], q1[0], s1[1], q1[1]}; rp[3] = (f32x4){s1[2], q1[2], s1[3], q1[3]};
            }
        }
        EPI_BARRIER();
        if (tid < 256) { const LAS f32x2* r2 = (const LAS f32x2*)red; const int bj = tid >> 7, t = tid & 127;
            const f32x2 a = r2[(0 * 2 + bj) * 128 + t], b = r2[(1 * 2 + bj) * 128 + t];
            PART[(size_t)u.pm * MT + 256 * u.pn + tid] = a + b; }
    }
};

struct EpiMix {
    static __host__ __device__ __forceinline__ unsigned boff(int R, int C, int nKt) { return (unsigned)lds_byte((R & ~31) + perm32(R & 31), C); }
    bf16_t* Y; const bf16_t* VT; const bf16_t* WS; const f32x2* stats; const float* lng; const float* lnb; const float* bs;
    __device__ __forceinline__ void operator()(f32x4 (&acc)[2][2][4][2], const Unit& u_, int wr_, int wc_, int fr_, int fq_, LAS unsigned char* lds, int tid_) const {
        Unit u; u.pm = u_.pm; u.pn = u_.pn; u.fresh = __builtin_amdgcn_readfirstlane(u_.fresh); asm volatile("" : "+s"(u.pm), "+s"(u.pn));
        int tid = tid_; asm volatile("" : "+v"(tid));
        const int wid = __builtin_amdgcn_readfirstlane(tid >> 6), wr = wid >> 2, wc = wid & 3, fr = tid & 15, fq = (tid >> 4) & 3;
        LAS float* TSA = (LAS float*)(lds + EPI_OFF);
        LAS float* TSB = (LAS float*)(lds + EPI_OFF + 1024);
        const int grp = u.pn >> 1, j0 = 128 * u.pn;
        const int jx = j0 + 32 * wc + 8 * (fr >> 2) + (fr & 3);
        const bf16_t* vbase = VT + ((((size_t)(2 * u.pm) * 128 + 8 * u.pn + 2 * wc + (fr >> 3)) * 4) * 64 + (8 * ((fr >> 2) & 1) + (fr & 3)) * 4 + fq) * 8;
        u32x4 raw[2][4];
#pragma unroll
        for (int n = 0; n < 2; ++n)
#pragma unroll
            for (int k = 0; k < 4; ++k) raw[n][k] = *(const u32x4*)(vbase + n * 128 + 512 * k);
        if (u.fresh) {
            if (tid < 256) { const unsigned tok = 256u * u.pm + tid; f32x2 sq = stats[tok];
    #pragma unroll
                for (int p = 1; p < 8; ++p) sq += stats[(size_t)p * MT + tok];
                const float mean = sq.x * (1.0f / 2048.0f); float var = sq.y * (1.0f / 2048.0f) - mean * mean; var = var < 0.f ? 0.f : var;
                const float rstd = 1.0f / sqrtf(var + LN_EPS); TSA[tid] = rstd; TSB[tid] = -mean * rstd; }
        }
        float lg[2], lb[2];
#pragma unroll
        for (int n = 0; n < 2; ++n) { lg[n] = lng[jx + 4 * n]; lb[n] = lnb[jx + 4 * n]; }
        if (u.fresh) EPI_BARRIER();
#pragma unroll
        for (int ai = 0; ai < 2; ++ai) {
            bf16x8 Xf[2][4];
#pragma unroll
            for (int n = 0; n < 2; ++n)
#pragma unroll
                for (int k = 0; k < 4; ++k) {
                    const LAS f32x4* ta = (const LAS f32x4*)(TSA + 128 * ai + 32 * k + 8 * fq);
                    const LAS f32x4* tb = (const LAS f32x4*)(TSB + 128 * ai + 32 * k + 8 * fq);
                    const f32x4 a0 = ta[0], a1 = ta[1], b0 = tb[0], b1 = tb[1];
                    const f32x2 lg2 = (f32x2){lg[n], lg[n]}, lb2 = (f32x2){lb[n], lb[n]};
                    u32x4 o;
#pragma unroll
                    for (int h = 0; h < 4; ++h) { const unsigned wd = raw[n][k][h];
                        const f32x2 f = (f32x2){__uint_as_float(wd << 16), __uint_as_float(wd & 0xffff0000u)};
                        const f32x2 aa = h == 0 ? (f32x2){a0[0], a0[1]} : h == 1 ? (f32x2){a0[2], a0[3]} : h == 2 ? (f32x2){a1[0], a1[1]} : (f32x2){a1[2], a1[3]};
                        const f32x2 bb = h == 0 ? (f32x2){b0[0], b0[1]} : h == 1 ? (f32x2){b0[2], b0[3]} : h == 2 ? (f32x2){b1[0], b1[1]} : (f32x2){b1[2], b1[3]};
                        const f32x2 v = (f * aa + bb) * lg2 + lb2;
                        o[h] = cvt_pk_bf16(v.x, v.y); }
                    Xf[n][k] = __builtin_bit_cast(bf16x8, o);
                }
            if (ai == 0) {
#pragma unroll
                for (int n = 0; n < 2; ++n)
#pragma unroll
                    for (int k = 0; k < 4; ++k) raw[n][k] = *(const u32x4*)(vbase + (size_t)262144 + n * 128 + 512 * k);
            }
#pragma unroll
            for (int m = 0; m < 4; ++m) {
                const int t = 64 * wr + 16 * m + fr;
                const bf16_t* wp = WS + ((((size_t)grp * 8 + 4 * wr + m) * 4) * 64 + fr * 4 + fq) * 8;
                bf16x8 Yf[4];
#pragma unroll
                for (int k = 0; k < 4; ++k) Yf[k] = *(const bf16x8*)(wp + 512 * k);
                const float bst = bs[grp * 128 + t];
                f32x4 mx0 = (f32x4){0.f, 0.f, 0.f, 0.f}, mx1 = mx0;
#pragma unroll
                for (int k = 0; k < 4; ++k) { mx0 = __builtin_amdgcn_mfma_f32_16x16x32_bf16(Xf[0][k], Yf[k], mx0, 0, 0, 0); mx1 = __builtin_amdgcn_mfma_f32_16x16x32_bf16(Xf[1][k], Yf[k], mx1, 0, 0, 0); }
                const f32x4 y0 = silu4(acc[ai][1][m][0]) * (gelu4(acc[ai][0][m][0]) * (mx0 + bst));
                const f32x4 y1 = silu4(acc[ai][1][m][1]) * (gelu4(acc[ai][0][m][1]) * (mx1 + bst));
                u32x4 w; w.x = cvt_pk_bf16(y0[0], y0[1]); w.y = cvt_pk_bf16(y0[2], y0[3]); w.z = cvt_pk_bf16(y1[0], y1[1]); w.w = cvt_pk_bf16(y1[2], y1[3]);
                *(u32x4*)(Y + tiled_elem(256 * u.pm + 128 * ai + t, j0 + 32 * wc + 8 * fq, DE / 64)) = w;
            }
        }
    }
};

__device__ __forceinline__ f32x4 zero4() {
    f32x2 lo, hi;
    asm volatile("v_mov_b64 %0, 0" : "=v"(lo)); asm volatile("v_mov_b64 %0, 0" : "=v"(hi));
    return (f32x4){lo.x, lo.y, hi.x, hi.y};
}
template <class Epi>
__device__ __forceinline__ void gemm_phase(LAS unsigned char* lds, const GemmDesc g, const StaticOrder& S, const Epi& E) {
    const int tid = threadIdx.x, wid = __builtin_amdgcn_readfirstlane(tid >> 6), lane = tid & 63, wr = wid >> 2, wc = wid & 3, fr = lane & 15, fq = lane >> 4;
    const int K = g.K, nt = K / BK;
    unsigned voffA[2], voffB[2];
#pragma unroll
    for (int i = 0; i < 2; ++i) { int R, C; stage_rc(tid * 16 + i * 8192, R, C); voffA[i] = (unsigned)(tid * 16 + i * 8192); voffB[i] = Epi::boff(R, C, nt); }
    const size_t kstep = (size_t)16384;
    const size_t hstepA = g.hstepA, hstepB = g.hstepB;
    const unsigned ldsw = (unsigned)wid * 1024u;
    const int aoff = lds_byte(wr * 64 + fr, fq * 8), boff = lds_byte(wc * 32 + fr, fq * 8);
#define PG8_SA(b, h) (((b) * 2 + (h)) * HTB)
#define PG8_SB(b, h) ((4 + (b) * 2 + (h)) * HTB)
#define PG8_STAGE(bufoff, gbase, voff) do { _Pragma("unroll") for (int _i = 0; _i < 2; ++_i) \
        __builtin_amdgcn_global_load_lds((const unsigned*)((const char*)(gbase) + (voff)[_i]), (LAS unsigned*)(lds + (bufoff) + ldsw + _i * 8192), 16, 0, 0); } while (0)
#define PG8_LDA(dst, b, h) do { _Pragma("unroll") for (int m = 0; m < 4; ++m) _Pragma("unroll") for (int k = 0; k < 2; ++k) dst[m][k] = *(const LAS bf16x8*)(lds + PG8_SA(b, h) + aoff + m * 2048 + k * 1024); } while (0)
#define PG8_LDB(dst, b, h) do { _Pragma("unroll") for (int n = 0; n < 2; ++n) _Pragma("unroll") for (int k = 0; k < 2; ++k) dst[n][k] = *(const LAS bf16x8*)(lds + PG8_SB(b, h) + boff + n * 2048 + k * 1024); } while (0)
#define PG8_MMA(ai, bj, At, Bt) do { __builtin_amdgcn_s_setprio(1); _Pragma("unroll") for (int m = 0; m < 4; ++m) _Pragma("unroll") for (int n = 0; n < 2; ++n) _Pragma("unroll") for (int k = 0; k < 2; ++k) \
        acc[ai][bj][m][n] = __builtin_amdgcn_mfma_f32_16x16x32_bf16(Bt[n][k], At[m][k], acc[ai][bj][m][n], 0, 0, 0); __builtin_amdgcn_s_setprio(0); } while (0)
#define PG8_WAIT_V(n) asm volatile("s_waitcnt vmcnt(" #n ")" ::: "memory")
#define PG8_WAIT_L(n) asm volatile("s_waitcnt lgkmcnt(" #n ")" ::: "memory")
#define PG8_BAR __builtin_amdgcn_s_barrier()
#define PG8_SCHED __builtin_amdgcn_sched_barrier(0)
    Unit cur, nxt; int ui = 0;
    if (!S.next(0, cur)) return;
    cur.fresh = 1;
    f32x4 acc[2][2][4][2];
#pragma unroll
    for (int a = 0; a < 2; ++a)
#pragma unroll
        for (int b = 0; b < 2; ++b)
#pragma unroll
            for (int m = 0; m < 4; ++m)
#pragma unroll
                for (int n = 0; n < 2; ++n) acc[a][b][m][n] = zero4();
    bf16x8 At[4][2], B0[2][2], B1[2][2];
    const char* cA = (const char*)g.A + (size_t)cur.pm * g.tstepA; const char* cB = (const char*)g.Bt + (g.pnHalf ? (size_t)(cur.pn >> 1) * g.tstepB + (size_t)(cur.pn & 1) * 8192 : (size_t)cur.pn * g.tstepB);
    PG8_STAGE(PG8_SB(0, 0), cB, voffB); PG8_STAGE(PG8_SB(0, 1), cB + hstepB, voffB); PG8_STAGE(PG8_SA(0, 0), cA, voffA); PG8_STAGE(PG8_SA(0, 1), cA + hstepA, voffA);
    if (wr == 1) PG8_BAR;
    PG8_WAIT_V(2); PG8_BAR;
    PG8_STAGE(PG8_SB(1, 0), cB + kstep, voffB); PG8_STAGE(PG8_SA(1, 0), cA + kstep, voffA); PG8_STAGE(PG8_SB(1, 1), cB + hstepB + kstep, voffB);
    PG8_WAIT_V(6); PG8_BAR;
    for (;;) {
        const bool has_next = S.next(ui + 1, nxt);
        nxt.fresh = has_next ? (nxt.pm != cur.pm) : 0;
        const char* nA = has_next ? (const char*)g.A + (size_t)nxt.pm * g.tstepA : cA; const char* nB = has_next ? (const char*)g.Bt + (g.pnHalf ? (size_t)(nxt.pn >> 1) * g.tstepB + (size_t)(nxt.pn & 1) * 8192 : (size_t)nxt.pn * g.tstepB) : cB;
        for (int t = 0; t < nt; t += 2) {
            const bool last = (t == nt - 2);
            const char* a1 = cA + (size_t)(t + 1) * kstep;
            const char* a2 = last ? nA : cA + (size_t)(t + 2) * kstep; const char* b2 = last ? nB : cB + (size_t)(t + 2) * kstep;
            const char* a3 = a2 + kstep; const char* b3 = b2 + kstep;
            PG8_LDB(B0, 0, 0); PG8_LDB(B1, 0, 1); PG8_SCHED; PG8_LDA(At, 0, 0); PG8_STAGE(PG8_SA(1, 1), a1 + hstepA, voffA);
            PG8_WAIT_V(8); PG8_WAIT_L(0); PG8_BAR; PG8_MMA(0, 0, At, B0); PG8_MMA(0, 1, At, B1); PG8_BAR; PG8_SCHED;
            PG8_LDA(At, 0, 1); PG8_STAGE(PG8_SB(0, 0), b2, voffB); PG8_STAGE(PG8_SB(0, 1), b2 + hstepB, voffB); PG8_STAGE(PG8_SA(0, 0), a2, voffA);
            PG8_WAIT_V(8); PG8_WAIT_L(0); PG8_BAR; PG8_MMA(1, 0, At, B0); PG8_MMA(1, 1, At, B1); PG8_BAR; PG8_SCHED;
            PG8_LDB(B0, 1, 0); PG8_LDB(B1, 1, 1); PG8_SCHED; PG8_LDA(At, 1, 0); PG8_STAGE(PG8_SA(0, 1), a2 + hstepA, voffA);
            PG8_WAIT_V(8); PG8_WAIT_L(0); PG8_BAR; PG8_MMA(0, 0, At, B0); PG8_MMA(0, 1, At, B1); PG8_BAR; PG8_SCHED;
            PG8_LDA(At, 1, 1); PG8_STAGE(PG8_SB(1, 0), b3, voffB); PG8_STAGE(PG8_SB(1, 1), b3 + hstepB, voffB); PG8_STAGE(PG8_SA(1, 0), a3, voffA);
            PG8_WAIT_V(8); PG8_WAIT_L(0); PG8_BAR; PG8_MMA(1, 0, At, B0); PG8_MMA(1, 1, At, B1); PG8_BAR; PG8_SCHED;
        }
        if (wr == 0) PG8_BAR;
        E(acc, cur, wr, wc, fr, fq, lds, tid);
        if (!has_next) break;
#pragma unroll
        for (int a = 0; a < 2; ++a)
#pragma unroll
            for (int b = 0; b < 2; ++b)
#pragma unroll
                for (int m = 0; m < 4; ++m)
#pragma unroll
                    for (int n = 0; n < 2; ++n) acc[a][b][m][n] = zero4();
        cur = nxt; cA = nA; cB = nB; ++ui;
        if (wr == 1) PG8_BAR;
    }
    PG8_WAIT_V(0);
    PG8_BAR;
#undef PG8_SA
#undef PG8_SB
#undef PG8_STAGE
#undef PG8_LDA
#undef PG8_LDB
#undef PG8_MMA
#undef PG8_WAIT_V
#undef PG8_WAIT_L
#undef PG8_BAR
#undef PG8_SCHED
}

__device__ __forceinline__ unsigned f2bf(float f) { unsigned u = __builtin_bit_cast(unsigned, f); return (u + 0x7fffu + ((u >> 16) & 1u)) >> 16; }
__device__ __forceinline__ unsigned pk2(float lo, float hi) { return f2bf(lo) | (f2bf(hi) << 16); }
__device__ __forceinline__ float wave_sum(float v) {
#pragma unroll
    for (int o = 1; o < 64; o <<= 1) v += __shfl_xor(v, o);
    return v;
}
__device__ __forceinline__ void p0_transpose_item(const float* W, int K, int N, bf16_t* WT, LAS float* scr, int item, int lane) {
    const int nblk = N / 32, kb = item / nblk, nb = item % nblk, k0 = 64 * kb, n0 = 32 * nb;
    float tv[32];
#pragma unroll
    for (int i = 0; i < 32; ++i) { const int kk = 2 * i + (lane >> 5); tv[i] = W[(size_t)(k0 + kk) * N + n0 + (lane & 31)]; }
#pragma unroll
    for (int i = 0; i < 32; ++i) { const int kk = 2 * i + (lane >> 5); scr[kk * 33 + (lane & 31)] = tv[i]; }
    asm volatile("s_waitcnt lgkmcnt(0)" ::: "memory");
    const int c = lane & 7;
#pragma unroll
    for (int jx = 0; jx < 4; ++jx) { const int n = (lane >> 3) + 8 * jx; const LAS float* s = scr + (8 * c) * 33 + n;
        u32x4 o; o.x = pk2(s[0 * 33], s[1 * 33]); o.y = pk2(s[2 * 33], s[3 * 33]); o.z = pk2(s[4 * 33], s[5 * 33]); o.w = pk2(s[6 * 33], s[7 * 33]);
        *(u32x4*)(WT + tiled_elem(n0 + n, k0 + 8 * c, K / 64)) = o; }
    asm volatile("s_waitcnt lgkmcnt(0)" ::: "memory");
}

#define XB_TMO      128
#define XB_XCNT(j)  (256  + 64 * (j))
#define XB_XSUB(j)  (1280 + 64 * (j))
#define XB_XGEN(j)  (2304 + 64 * (j))
#define XB_TOP      3328
#define XB_TOPGEN   3392
#define XB_SPIN_CAP (1u << 18)
__device__ __forceinline__ unsigned xb_ld(unsigned* p)              { return __hip_atomic_load(p, __ATOMIC_RELAXED, __HIP_MEMORY_SCOPE_AGENT); }
__device__ __forceinline__ unsigned xb_add(unsigned* p, unsigned v) { return __hip_atomic_fetch_add(p, v, __ATOMIC_RELAXED, __HIP_MEMORY_SCOPE_AGENT); }
__device__ __forceinline__ unsigned xb_xcc_id() { return (unsigned)__builtin_amdgcn_s_getreg((3 << 11) | 20) & 0xFu; }
#define XB_SPIN(cond, bar) do { unsigned _sp = 0; while (cond) { __builtin_amdgcn_s_sleep(1); \
    if ((++_sp & 255u) == 0u) { if (xb_ld(&(bar)[XB_TMO])) break; if (_sp > XB_SPIN_CAP) { atomicAdd(&(bar)[XB_TMO], 1u); break; } } } } while (0)
struct XcdBarrier { unsigned* bar; unsigned x; volatile LAS unsigned* st; };
__device__ __forceinline__ XcdBarrier xcd_barrier_post(unsigned* bar, volatile LAS unsigned* st) {
    XcdBarrier b; b.bar = bar; b.x = xb_xcc_id(); b.st = st;
    if (threadIdx.x == 0) (void)xb_add(&bar[XB_XCNT(b.x)], 1u);
    return b;
}
__device__ __forceinline__ void xcd_barrier_complete(unsigned* bar, unsigned x, unsigned& nloc, unsigned& nx) {
    const unsigned G = gridDim.x * gridDim.y * gridDim.z;
    unsigned sum, cnt, mine, sp = 0u;
    for (;;) {
        sum = 0u; cnt = 0u; mine = 0u;
#pragma unroll
        for (unsigned j = 0; j < 16; ++j) { const unsigned c = xb_ld(&bar[XB_XCNT(j)]); sum += c; cnt += (c > 0u) ? 1u : 0u; mine = (j == x) ? c : mine; }
        if (sum == G) break;
        __builtin_amdgcn_s_sleep(1);
        if ((++sp & 255u) == 0u) { if (xb_ld(&bar[XB_TMO])) break; if (sp > XB_SPIN_CAP) { atomicAdd(&bar[XB_TMO], 1u); break; } }
    }
    nloc = mine > 0u ? mine : 1u; nx = cnt > 0u ? cnt : 1u;
}
__device__ __forceinline__ void xcd_barrier(const XcdBarrier& b) {
    asm volatile("s_waitcnt vmcnt(0)" ::: "memory");
    __syncthreads();
    if (threadIdx.x == 0) {
        unsigned* bar = b.bar;
        __builtin_amdgcn_s_waitcnt(0);
        unsigned nloc = b.st[0], nx = b.st[1];
        if (nloc == 0u) { xcd_barrier_complete(bar, b.x, nloc, nx); b.st[0] = nloc; b.st[1] = nx; }
        const unsigned old = xb_add(&bar[XB_XSUB(b.x)], 1u);
        const unsigned gen = old / nloc;
        if (old + 1u == (gen + 1u) * nloc) {
            __builtin_amdgcn_fence(__ATOMIC_RELEASE, "agent");
            asm volatile("s_waitcnt vmcnt(0)" ::: "memory");
            const unsigned og = xb_add(&bar[XB_TOP], 1u);
            const unsigned tg = og / nx;
            if (og + 1u == (tg + 1u) * nx) xb_add(&bar[XB_TOPGEN], 1u);
            else XB_SPIN(xb_ld(&bar[XB_TOPGEN]) == tg, bar);
            __builtin_amdgcn_fence(__ATOMIC_ACQUIRE, "agent");
            xb_add(&bar[XB_XGEN(b.x)], 1u);
            asm volatile("s_waitcnt vmcnt(0)" ::: "memory");
        } else {
            XB_SPIN(xb_ld(&bar[XB_XGEN(b.x)]) == gen, bar);
            __builtin_amdgcn_fence(__ATOMIC_ACQUIRE, "agent");
            asm volatile("s_waitcnt vmcnt(0)" ::: "memory");
        }
    }
    __syncthreads();
}

struct Args { const float* in[16]; float* out; unsigned char* ws; int ph_lo, ph_hi; };

__device__ __forceinline__ void norm_rows_bf16(const float* X, bf16_t* H, const float* gam, const float* modl, int gw, int NGW, int lane) {
    for (int m0 = gw * 4; m0 < MT; m0 += NGW * 4) {
        const int b = m0 >> 13;
        f32x4 v[4][4]; float ss[4];
#pragma unroll
        for (int r = 0; r < 4; ++r) { const f32x4* xr = (const f32x4*)(X + (size_t)(m0 + r) * DM) + lane;
#pragma unroll
            for (int j = 0; j < 4; ++j) v[r][j] = xr[64 * j]; }
#pragma unroll
        for (int r = 0; r < 4; ++r) { float s = 0.f;
#pragma unroll
            for (int j = 0; j < 4; ++j) s += (v[r][j][0] * v[r][j][0] + v[r][j][1] * v[r][j][1]) + (v[r][j][2] * v[r][j][2] + v[r][j][3] * v[r][j][3]);
            ss[r] = 1.0f / sqrtf(wave_sum(s) * (1.0f / DM) + RMS_EPS); }
        const float* mb = modl + (size_t)b * 3072;
#pragma unroll
        for (int j = 0; j < 4; ++j) { const int col = 256 * j + 4 * lane;
            const f32x4 gg = *(const f32x4*)(gam + col), sh = *(const f32x4*)(mb + col), sc = *(const f32x4*)(mb + 1024 + col);
            const f32x4 mul = gg * (sc + 1.0f);
#pragma unroll
            for (int r = 0; r < 4; ++r) { const f32x4 o = v[r][j] * ss[r] * mul + sh;
                u32x2 w; w.x = pk2(o[0], o[1]); w.y = pk2(o[2], o[3]);
                *(u32x2*)(H + tiled_elem(m0 + r, col, DM / 64)) = w; } }
    }
}

__global__ void __launch_bounds__(512, 2) fwd_megakernel(Args args) {
    extern __shared__ __attribute__((aligned(16))) unsigned char lds_raw[];
    LAS unsigned char* lds = (LAS unsigned char*)lds_raw;
    cg::grid_group grid = cg::this_grid();
    const int tid = threadIdx.x, lane = tid & 63, wave = __builtin_amdgcn_readfirstlane(tid >> 6);
    const int G = gridDim.x, bx = blockIdx.x, gw = bx * 8 + wave, NGW = G * 8;
    unsigned char* ws = args.ws;
    const float* x = args.in[0]; const float* cvec = args.in[1]; const float* mod_w = args.in[2]; const float* mod_b = args.in[3]; const float* norm_g = args.in[4];
    const float* a_w_in = args.in[5]; const float* a_conv_w = args.in[6]; const float* a_conv_b = args.in[7]; const float* a_w_out = args.in[8];
    const float* b_w_in = args.in[9]; const float* b_ln_g = args.in[10]; const float* b_ln_b = args.in[11]; const float* b_w_s = args.in[12]; const float* b_b_s = args.in[13];
    const float* b_w_out = args.in[14]; const float* final_g = args.in[15];
    float* out = args.out;
    float* MOD = (float*)(ws + WS_MOD); f32x2* PART = (f32x2*)(ws + WS_PART);
    float* HG = (float*)(ws + WS_HG); float* GG = (float*)(ws + WS_GG); float* PC = (float*)(ws + WS_PC);
    bf16_t* WSb = (bf16_t*)(ws + WS_WS); bf16_t* W1t = (bf16_t*)(ws + WS_W1); bf16_t* W2t = (bf16_t*)(ws + WS_W2); bf16_t* W3t = (bf16_t*)(ws + WS_W3); bf16_t* W4t = (bf16_t*)(ws + WS_W4);
    bf16_t* H = (bf16_t*)(ws + WS_H); bf16_t* Y = (bf16_t*)(ws + WS_Y); bf16_t* VT = (bf16_t*)(ws + WS_VT);
    const int lo = args.ph_lo, hi = args.ph_hi;
    if (lo < 0) grid.sync();
#define IN(k) (lo <= (k) && (k) < hi)
#define SEAM(k) do { if (IN(k) && IN((k) + 1)) xcd_barrier(xbar); } while (0)
    volatile LAS unsigned* MISC = (volatile LAS unsigned*)(lds + EPI_OFF + 8192);
    if (tid < 2) MISC[tid] = 0u;
    __syncthreads();
    XcdBarrier xbar = xcd_barrier_post((unsigned*)(ws + WS_CTL) + 4096, MISC);

    if (IN(0)) {
        LAS float* sc = (LAS float*)lds;
        for (int it = bx; it < 384; it += G) {
            const int l = it / 192, r = it % 192, ks = r / 6, cgp = r % 6;
            __syncthreads();
            if (tid < 128) { const int b = tid >> 5, kk = tid & 31; const float cv = cvec[b * DM + ks * 32 + kk]; sc[tid] = cv / (1.0f + __expf(-cv)); }
            __syncthreads();
            const int n = cgp * 512 + tid;
            const float* w = mod_w + ((size_t)l * DM + ks * 32) * 3072 + n;
            float wv[32];
#pragma unroll
            for (int kk = 0; kk < 32; ++kk) wv[kk] = w[(size_t)kk * 3072];
            float a0 = 0.f, a1 = 0.f, a2 = 0.f, a3 = 0.f;
#pragma unroll
            for (int kk = 0; kk < 32; ++kk) { a0 += sc[kk] * wv[kk]; a1 += sc[32 + kk] * wv[kk]; a2 += sc[64 + kk] * wv[kk]; a3 += sc[96 + kk] * wv[kk]; }
            if (ks == 0) { const float bv = mod_b[l * 3072 + n]; a0 += bv; a1 += bv; a2 += bv; a3 += bv; }
            float* mp = MOD + (size_t)l * 4 * 3072 + n;
            atomicAdd(mp, a0); atomicAdd(mp + 3072, a1); atomicAdd(mp + 2 * 3072, a2); atomicAdd(mp + 3 * 3072, a3);
        }
        __syncthreads();
        LAS float* scr = (LAS float*)(lds + wave * 16384);
        constexpr int I1 = (DM / 64) * (4 * DE / 32), I2 = (DE / 64) * (DM / 32), I3 = (DM / 64) * (3 * DE / 32), I4 = I2;
        for (int it = gw; it < I1 + I2 + I3 + I4; it += NGW) {
            int r = it;
            if (r < I1) { p0_transpose_item(a_w_in, DM, 4 * DE, W1t, scr, r, lane); continue; } r -= I1;
            if (r < I2) { p0_transpose_item(a_w_out, DE, DM, W2t, scr, r, lane); continue; } r -= I2;
            if (r < I3) { p0_transpose_item(b_w_in, DM, 3 * DE, W3t, scr, r, lane); continue; } r -= I3;
            p0_transpose_item(b_w_out, DE, DM, W4t, scr, r, lane);
        }
        for (int i = bx * 512 + tid; i < 8 * 128 * 128; i += G * 512) { const int s = i & 127, t = (i >> 7) & 127, gq = i >> 14;
            WSb[(((gq * 8 + (t >> 4)) * 4 + (s >> 5)) * 64 + (t & 15) * 4 + ((s >> 3) & 3)) * 8 + (s & 7)] = (bf16_t)f2bf(s <= t ? b_w_s[i] : 0.0f); }
    }
    SEAM(0);
    if (IN(1)) norm_rows_bf16(x, H, norm_g, MOD, gw, NGW, lane);
    SEAM(1);
    if (IN(2)) {
        GemmDesc g{H, W1t, DM, (size_t)256 * DM * 2, (size_t)128 * DM * 2, (size_t)128 * DM * 2, (size_t)4096 * DM * 2, MT / 256, 32, 1};
        StaticOrder S; S.init(g.nM, g.nN, G, bx);
        EpiConv E{Y, a_conv_w, a_conv_b, HG, GG, PC};
        gemm_phase<EpiConv>(lds, g, S, E);
    }
    if (IN(2) && IN(4)) xcd_barrier(xbar);
    if (IN(4)) {
        GemmDesc g{Y, W2t, DE, (size_t)256 * DE * 2, (size_t)128 * DE * 2, (size_t)256 * DE * 2, (size_t)128 * DE * 2, MT / 256, 4, 0};
        StaticOrder S; S.init(g.nM, g.nN, G, bx);
        { Unit fu;
          for (int ui = 0; S.next(ui, fu); ++ui) {
            const int pm = fu.pm; if ((pm & 31) == 0) continue;
            for (int it = tid; it < 1024; it += 512) {
                const int i = it >> 9, j = (it & 511) * 4;
                const f32x4 g = *(const f32x4*)(GG + ((size_t)(pm * 2 + i)) * 2048 + j), pc = *(const f32x4*)(PC + ((size_t)(pm * 2 + i)) * 2048 + j);
                const f32x4 c15 = *(const f32x4*)(HG + ((size_t)((pm - 1) * 2 + 1)) * 2048 + j), c14 = *(const f32x4*)(HG + ((size_t)((pm - 1) * 2 + 0)) * 2048 + j);
                const f32x4 w0 = *(const f32x4*)(a_conv_w + j), w1 = *(const f32x4*)(a_conv_w + 2048 + j);
                const f32x4 add = (i == 0) ? (w1 * c15 + w0 * c14) : (w0 * c15);
                const f32x4 yv = g * (pc + add);
                u32x2 w; w.x = pk2(yv[0], yv[1]); w.y = pk2(yv[2], yv[3]);
                *(u32x2*)(Y + tiled_elem(pm * 256 + i, j, DE / 64)) = w;
            }
          }
          asm volatile("s_waitcnt vmcnt(0)" ::: "memory"); __syncthreads(); }
        EpiResNorm<0> E{x, out, H, MOD + 2048, norm_g + DM, MOD + 4 * 3072, (float*)(ws + WS_XS), (unsigned*)(ws + WS_CTL) + 8192, (bf16_t*)(ws + WS_X1)};
        gemm_phase<EpiResNorm<0>>(lds, g, S, E);
    }
    if (IN(4) && IN(6)) xcd_barrier(xbar);
    if (IN(6)) {
        GemmDesc g{W3t + (size_t)2048 * DM, H, DM, (size_t)256 * DM * 2, (size_t)128 * DM * 2, (size_t)256 * DM * 2, (size_t)128 * DM * 2, 8, MT / 256, 0};
        StaticOrder S; S.init(g.nM, g.nN, G, bx);
        EpiV E{VT, PART};
        gemm_phase<EpiV>(lds, g, S, E);
    }
    SEAM(6);
    if (IN(7)) {
        GemmDesc g{H, W3t, DM, (size_t)256 * DM * 2, (size_t)128 * DM * 2, (size_t)128 * DM * 2, (size_t)4096 * DM * 2, MT / 256, 16, 0};
        StaticOrder S; S.init(g.nM, g.nN, G, bx);
        EpiMix E{Y, VT, WSb, PART, b_ln_g, b_ln_b, b_b_s};
        gemm_phase<EpiMix>(lds, g, S, E);
    }
    SEAM(7);
    if (IN(8)) {
        GemmDesc g{Y, W4t, DE, (size_t)256 * DE * 2, (size_t)128 * DE * 2, (size_t)256 * DE * 2, (size_t)128 * DE * 2, MT / 256, 4, 0};
        StaticOrder S; S.init(g.nM, g.nN, G, bx);
        EpiResNorm<1> E{out, out, nullptr, MOD + 4 * 3072 + 2048, final_g, nullptr, (float*)(ws + WS_XS) + 128 * 4 * 256, (unsigned*)(ws + WS_CTL) + 8192 + 128 * 64, (bf16_t*)(ws + WS_X1)};
        gemm_phase<EpiResNorm<1>>(lds, g, S, E);
    }
#undef IN
#undef SEAM
}

#ifndef MK_MULTI
#define MK_MULTI 0
#endif
extern "C" void kernel_launch(void* const* d_in, const int* in_sizes, int n_in, void* d_out, int out_size, void* d_ws, size_t ws_size, hipStream_t stream) {
    static int grid = 0;
    if (grid == 0) {
        if (n_in != 16 || out_size != MT * DM || ws_size < WS_END) { fprintf(stderr, "kernel_launch: unexpected shapes (n_in %d out %d ws %zu)\n", n_in, out_size, ws_size); grid = -1; return; }
        int dev = 0, cus = 0, per_cu = 0;
        hipGetDevice(&dev); hipDeviceGetAttribute(&cus, hipDeviceAttributeMultiprocessorCount, dev);
        if (hipFuncSetAttribute((const void*)fwd_megakernel, hipFuncAttributeMaxDynamicSharedMemorySize, LDS_BYTES) != hipSuccess) { fprintf(stderr, "kernel_launch: hipFuncSetAttribute failed\n"); grid = -1; return; }
        if (hipOccupancyMaxActiveBlocksPerMultiprocessor(&per_cu, (const void*)fwd_megakernel, 512, LDS_BYTES) != hipSuccess || per_cu < 1) { fprintf(stderr, "kernel_launch: occupancy query says %d\n", per_cu); per_cu = 1; }
        (void)hipGetLastError();
        grid = cus * per_cu;
    }
    if (grid < 0) return;
    hipMemsetAsync((char*)d_ws + WS_CTL, 0, CTL_ZERO_BYTES, stream);
    Args a{};
    for (int i = 0; i < 16; ++i) a.in[i] = (const float*)d_in[i];
    a.out = (float*)d_out; a.ws = (unsigned char*)d_ws;
#if MK_MULTI
    for (int p = 0; p < 10; ++p) { a.ph_lo = p; a.ph_hi = p + 1; hipLaunchKernelGGL(fwd_megakernel, dim3(grid), dim3(512), LDS_BYTES, stream, a); }
#else
    a.ph_lo = 0; a.ph_hi = 10;
    void* kargs[] = {&a};
    hipError_t e = hipLaunchCooperativeKernel((const void*)fwd_megakernel, dim3(grid), dim3(512), kargs, LDS_BYTES, stream);
    if (e != hipSuccess) fprintf(stderr, "cooperative launch failed: %s (grid %d)\n", hipGetErrorString(e), grid);
#endif
}
```
